# Optimizing an MI355X kernel written in HIP

```python
import math
import jax
import jax.numpy as jnp
from jax import lax
import numpy as np


D_MODEL = 1024
BATCH = 4
SEQ = 8192
DEPTH = 2

GLA_HEADS = 4
GLA_DK = 64
GLA_DV = 128
GLA_GATE_RANK = 16
GLA_TAU = 16.0
GLA_CHUNK = 64
MLA_HEADS = 8
MLA_Q_RANK = 256
MLA_KV_RANK = 128
MLA_NOPE = 64
MLA_ROPE = 32
MLA_V = 64
ROPE_THETA = 10000.0
DSA_HEADS = 8
DSA_HEAD_DIM = 64
IDX_HEADS = 8
IDX_DIM = 64
TOPK_MAX = 256
S5_GROUPS = 32
S5_GROUP_CH = 16
S5_STATE = 64
S5_DT_MIN = 0.001
S5_DT_MAX = 0.1
D_FF = 4 * D_MODEL
Q_BLOCK = 128
LN_EPS = 1e-5
DEEPNORM_ALPHA = (2 * DEPTH) ** 0.25
DEEPNORM_BETA = (8 * DEPTH) ** -0.25

L0_SPLITS = (GLA_HEADS * GLA_DK, GLA_HEADS * GLA_DK, GLA_HEADS * GLA_DV, GLA_GATE_RANK, GLA_HEADS * GLA_DV, MLA_Q_RANK, MLA_KV_RANK, MLA_ROPE)
L1_SPLITS = (DSA_HEADS * DSA_HEAD_DIM, DSA_HEADS * DSA_HEAD_DIM, DSA_HEADS * DSA_HEAD_DIM, IDX_HEADS * IDX_DIM, IDX_DIM, IDX_HEADS, S5_GROUPS * S5_GROUP_CH)
L0_IN = sum(L0_SPLITS)
L1_IN = sum(L1_SPLITS)
MIX0 = GLA_HEADS * GLA_DV + MLA_HEADS * MLA_V
MIX1 = DSA_HEADS * DSA_HEAD_DIM + S5_GROUPS * S5_GROUP_CH

kernel_name = 'hybrid_gla_mla_dsa_s5_block'


def _split(h, sizes):
    out = []
    off = 0
    for s in sizes:
        out.append(h[..., off:off + s])
        off += s
    return out


def _layernorm(x, g, b):
    xf = x.astype(jnp.float32)
    mu = jnp.mean(xf, -1, keepdims=True)
    var = jnp.mean(jnp.square(xf - mu), -1, keepdims=True)
    return ((xf - mu) * lax.rsqrt(var + LN_EPS) * g + b).astype(x.dtype)


def _rmsnorm(x, g):
    xf = x.astype(jnp.float32)
    return (xf * lax.rsqrt(jnp.mean(jnp.square(xf), -1, keepdims=True) + LN_EPS) * g).astype(x.dtype)


def _rope(t, pos):
    half = t.shape[-1] // 2
    inv_freq = ROPE_THETA ** (-jnp.arange(half, dtype=jnp.float32) / half)
    ang = pos.astype(jnp.float32)[:, :, None, None] * inv_freq
    cos, sin = jnp.cos(ang), jnp.sin(ang)
    tf = t.astype(jnp.float32)
    t1, t2 = tf[..., :half], tf[..., half:]
    return jnp.concatenate([t1 * cos - t2 * sin, t2 * cos + t1 * sin], -1).astype(t.dtype)


def _gla(q, k, v, log_a):
    b_, l_, h_, dk = q.shape
    dv = v.shape[-1]
    n_chunks = l_ // GLA_CHUNK

    def to_chunks(t):
        return t.astype(jnp.float32).reshape(b_, n_chunks, GLA_CHUNK, h_, t.shape[-1]).transpose(0, 3, 1, 2, 4)

    qc, kc, vc, gc = (to_chunks(t) for t in (q, k, v, log_a))
    cum = jnp.cumsum(gc, axis=3)
    cum_last = cum[:, :, :, -1:, :]
    q_dec = qc * jnp.exp(cum)
    k_inv = kc * jnp.exp(-cum)
    causal = jnp.tril(jnp.ones((GLA_CHUNK, GLA_CHUNK), dtype=bool))
    att = jnp.where(causal, jnp.einsum('bhnid,bhnjd->bhnij', q_dec, k_inv), 0.0)
    o_intra = jnp.einsum('bhnij,bhnje->bhnie', att, vc)
    k_end = kc * jnp.exp(cum_last - cum)
    chunk_kv = jnp.einsum('bhncd,bhnce->nbhde', k_end, vc)
    chunk_decay = jnp.exp(cum_last[:, :, :, 0, :]).transpose(2, 0, 1, 3)

    def step(state, inp):
        dec, kv = inp
        return dec[..., None] * state + kv, state

    s0 = jnp.zeros((b_, h_, dk, dv), jnp.float32)
    _, s_prev = lax.scan(step, s0, (chunk_decay, chunk_kv))
    o_inter = jnp.einsum('bhncd,nbhde->bhnce', q_dec, s_prev)
    return (o_intra + o_inter).transpose(0, 2, 3, 1, 4).reshape(b_, l_, h_, dv)


def _causal_block_attention(q, k, v, scale):
    b_, l_, h_, dq = q.shape
    dv = v.shape[-1]
    nb = l_ // Q_BLOCK
    qb = q.reshape(b_, nb, Q_BLOCK, h_, dq).transpose(1, 0, 2, 3, 4)
    key_pos = jnp.arange(l_)

    def one_block(args):
        qi, bi = args
        s = jnp.einsum('bqhd,bshd->bhqs', qi, k).astype(jnp.float32) * scale
        qpos = bi * Q_BLOCK + jnp.arange(Q_BLOCK)
        s = jnp.where((key_pos[None, :] <= qpos[:, None])[None, None], s, -jnp.inf)
        p = jax.nn.softmax(s, axis=-1)
        return jnp.einsum('bhqs,bshe->bqhe', p.astype(v.dtype), v)

    out = lax.map(one_block, (qb, jnp.arange(nb)))
    return out.transpose(1, 0, 2, 3, 4).reshape(b_, l_, h_, dv)


def _dsa(q, k, v, q_idx, k_idx, w_idx):
    b_, l_, h_, dh = q.shape
    topk = min(TOPK_MAX, l_ // 4)
    nb = l_ // Q_BLOCK

    def blocks(t):
        return t.reshape((b_, nb, Q_BLOCK) + t.shape[2:]).swapaxes(0, 1)

    key_pos = jnp.arange(l_)
    gather = jax.vmap(lambda kb, ib: kb[ib])

    def one_block(args):
        qi, qii, wi, bi = args
        qpos = bi * Q_BLOCK + jnp.arange(Q_BLOCK)
        logits = jnp.einsum('bqhd,bsd->bqhs', qii, k_idx).astype(jnp.float32) * (IDX_DIM ** -0.5)
        score = jnp.einsum('bqhs,bqh->bqs', jax.nn.relu(logits), wi.astype(jnp.float32))
        score = jnp.where((key_pos[None, :] <= qpos[:, None])[None], score, -jnp.inf)
        _, sel = lax.top_k(score, topk)
        sel_ok = sel <= qpos[None, :, None]
        k_sel = gather(k, sel)
        v_sel = gather(v, sel)
        s = jnp.einsum('bqhd,bqkhd->bhqk', qi, k_sel).astype(jnp.float32) * (dh ** -0.5)
        s = jnp.where(sel_ok[:, None], s, -jnp.inf)
        p = jax.nn.softmax(s, axis=-1)
        return jnp.einsum('bhqk,bqkhd->bqhd', p.astype(v.dtype), v_sel)

    out = lax.map(one_block, (blocks(q), blocks(q_idx), blocks(w_idx), jnp.arange(nb)))
    return out.swapaxes(0, 1).reshape(b_, l_, h_, dh)


def _s5(u, a_re, a_im, b_re, b_im, c_re, c_im, d_skip, log_step):
    b_, l_, _ = u.shape
    uf = u.astype(jnp.float32).reshape(b_, l_, S5_GROUPS, S5_GROUP_CH)
    lam_re = jnp.minimum(a_re.astype(jnp.float32), -1e-4)
    lam_im = a_im.astype(jnp.float32)
    dt = jnp.exp(log_step.astype(jnp.float32))[:, None]
    mag = jnp.exp(lam_re * dt)
    abar_re = mag * jnp.cos(lam_im * dt)
    abar_im = mag * jnp.sin(lam_im * dt)
    den = jnp.square(lam_re) + jnp.square(lam_im)
    nr = abar_re - 1.0
    ni = abar_im
    coef_re = (nr * lam_re + ni * lam_im) / den
    coef_im = (ni * lam_re - nr * lam_im) / den
    bf_re, bf_im = b_re.astype(jnp.float32), b_im.astype(jnp.float32)
    bbar_re = coef_re[..., None] * bf_re - coef_im[..., None] * bf_im
    bbar_im = coef_re[..., None] * bf_im + coef_im[..., None] * bf_re
    bu_re = jnp.einsum('blgc,gpc->blgp', uf, bbar_re)
    bu_im = jnp.einsum('blgc,gpc->blgp', uf, bbar_im)
    at_re = jnp.broadcast_to(abar_re, bu_re.shape)
    at_im = jnp.broadcast_to(abar_im, bu_im.shape)

    def combine(e1, e2):
        a1r, a1i, b1r, b1i = e1
        a2r, a2i, b2r, b2i = e2
        return (a2r * a1r - a2i * a1i,
                a2r * a1i + a2i * a1r,
                a2r * b1r - a2i * b1i + b2r,
                a2r * b1i + a2i * b1r + b2i)

    _, _, x_re, x_im = lax.associative_scan(combine, (at_re, at_im, bu_re, bu_im), axis=1)
    y = (jnp.einsum('blgp,gcp->blgc', x_re, c_re.astype(jnp.float32))
         - jnp.einsum('blgp,gcp->blgc', x_im, c_im.astype(jnp.float32)))
    y = y.reshape(b_, l_, S5_GROUPS * S5_GROUP_CH) + d_skip.astype(jnp.float32) * u.astype(jnp.float32)
    return y.astype(u.dtype)


def _mixer_gla_mla(x, positions, w_in, gla_wg2, gla_bg, gla_norm, mla_q_norm, mla_w_uq, mla_kv_norm, mla_w_ukv, w_out):
    b_, l_, _ = x.shape
    h = x @ w_in
    q, k, v, g_lr, r, c_q, c_kv, k_rope = _split(h, L0_SPLITS)
    gq = q.reshape(b_, l_, GLA_HEADS, GLA_DK) * (GLA_DK ** -0.5)
    gk = k.reshape(b_, l_, GLA_HEADS, GLA_DK)
    gv = v.reshape(b_, l_, GLA_HEADS, GLA_DV)
    log_a = (jax.nn.log_sigmoid((g_lr @ gla_wg2 + gla_bg).astype(jnp.float32)) / GLA_TAU).reshape(b_, l_, GLA_HEADS, GLA_DK)
    o = _rmsnorm(_gla(gq, gk, gv, log_a), gla_norm.reshape(GLA_HEADS, GLA_DV))
    o_gla = (o.reshape(b_, l_, GLA_HEADS * GLA_DV) * jax.nn.silu(r.astype(jnp.float32))).astype(x.dtype)
    qm = (_rmsnorm(c_q, mla_q_norm) @ mla_w_uq).reshape(b_, l_, MLA_HEADS, MLA_NOPE + MLA_ROPE)
    kvm = (_rmsnorm(c_kv, mla_kv_norm) @ mla_w_ukv).reshape(b_, l_, MLA_HEADS, MLA_NOPE + MLA_V)
    q_nope, q_rot = qm[..., :MLA_NOPE], _rope(qm[..., MLA_NOPE:], positions)
    k_nope, vm = kvm[..., :MLA_NOPE], kvm[..., MLA_NOPE:]
    k_rot = _rope(k_rope[:, :, None, :], positions)
    qf = jnp.concatenate([q_nope, q_rot], -1)
    kf = jnp.concatenate([k_nope, jnp.broadcast_to(k_rot, (b_, l_, MLA_HEADS, MLA_ROPE))], -1)
    o_mla = _causal_block_attention(qf, kf, vm, (MLA_NOPE + MLA_ROPE) ** -0.5).reshape(b_, l_, MLA_HEADS * MLA_V)
    return jnp.concatenate([o_gla, o_mla], -1) @ w_out


def _mixer_dsa_s5(x, w_in, s5_a_re, s5_a_im, s5_b_re, s5_b_im, s5_c_re, s5_c_im, s5_d, s5_log_step, glu_w, glu_b, w_out):
    b_, l_, _ = x.shape
    h = x @ w_in
    q, k, v, qi, ki, wi, u = _split(h, L1_SPLITS)
    o_dsa = _dsa(q.reshape(b_, l_, DSA_HEADS, DSA_HEAD_DIM),
                 k.reshape(b_, l_, DSA_HEADS, DSA_HEAD_DIM),
                 v.reshape(b_, l_, DSA_HEADS, DSA_HEAD_DIM),
                 qi.reshape(b_, l_, IDX_HEADS, IDX_DIM),
                 ki,
                 wi * (IDX_HEADS ** -0.5)).reshape(b_, l_, DSA_HEADS * DSA_HEAD_DIM)
    y = jax.nn.gelu(_s5(u, s5_a_re, s5_a_im, s5_b_re, s5_b_im, s5_c_re, s5_c_im, s5_d, s5_log_step))
    o_s5 = y * jax.nn.sigmoid(y @ glu_w + glu_b)
    return jnp.concatenate([o_dsa, o_s5], -1) @ w_out


def _sq_relu_mlp(x, w1, w2):
    return jnp.square(jax.nn.relu(x @ w1)) @ w2


def setup_inputs(seed: int = 0) -> dict:
    key = jax.random.key(seed)
    ks = list(jax.random.split(key, 64))

    def nrm(shape, scale):
        return jax.random.normal(ks.pop(), shape, jnp.float32) * scale

    def gain(n):
        return 1.0 + nrm((n,), 0.01)

    x = nrm((BATCH, SEQ, D_MODEL), 1.0)
    offs = jax.random.randint(ks.pop(), (BATCH, 1), 0, 1024, dtype=jnp.int32)
    positions = offs + jnp.arange(SEQ, dtype=jnp.int32)[None, :]
    s5w = S5_GROUPS * S5_GROUP_CH
    n_idx = jnp.arange(S5_STATE, dtype=jnp.float32)[None, :]
    return {
        'x': x,
        'positions': positions,
        'l0_w_in': nrm((D_MODEL, L0_IN), D_MODEL ** -0.5),
        'l0_gla_wg2': nrm((GLA_GATE_RANK, GLA_HEADS * GLA_DK), GLA_GATE_RANK ** -0.5),
        'l0_gla_bg': nrm((GLA_HEADS * GLA_DK,), 0.01),
        'l0_gla_norm': gain(GLA_HEADS * GLA_DV),
        'l0_mla_q_norm': gain(MLA_Q_RANK),
        'l0_mla_w_uq': nrm((MLA_Q_RANK, MLA_HEADS * (MLA_NOPE + MLA_ROPE)), MLA_Q_RANK ** -0.5),
        'l0_mla_kv_norm': gain(MLA_KV_RANK),
        'l0_mla_w_ukv': nrm((MLA_KV_RANK, MLA_HEADS * (MLA_NOPE + MLA_V)), MLA_KV_RANK ** -0.5),
        'l0_w_out': nrm((MIX0, D_MODEL), DEEPNORM_BETA * MIX0 ** -0.5),
        'l0_ln1_g': gain(D_MODEL),
        'l0_ln1_b': nrm((D_MODEL,), 0.01),
        'l0_mlp_w1': nrm((D_MODEL, D_FF), D_MODEL ** -0.5),
        'l0_mlp_w2': nrm((D_FF, D_MODEL), DEEPNORM_BETA * D_FF ** -0.5),
        'l0_ln2_g': gain(D_MODEL),
        'l0_ln2_b': nrm((D_MODEL,), 0.01),
        'l1_w_in': nrm((D_MODEL, L1_IN), D_MODEL ** -0.5),
        'l1_s5_a_re': -0.5 + nrm((S5_GROUPS, S5_STATE), 0.01),
        'l1_s5_a_im': math.pi * n_idx + nrm((S5_GROUPS, S5_STATE), 0.01),
        'l1_s5_b_re': nrm((S5_GROUPS, S5_STATE, S5_GROUP_CH), (2 * S5_GROUP_CH) ** -0.5),
        'l1_s5_b_im': nrm((S5_GROUPS, S5_STATE, S5_GROUP_CH), (2 * S5_GROUP_CH) ** -0.5),
        'l1_s5_c_re': nrm((S5_GROUPS, S5_GROUP_CH, S5_STATE), (2 * S5_STATE) ** -0.5),
        'l1_s5_c_im': nrm((S5_GROUPS, S5_GROUP_CH, S5_STATE), (2 * S5_STATE) ** -0.5),
        'l1_s5_d': nrm((s5w,), 1.0),
        'l1_s5_log_step': jax.random.uniform(ks.pop(), (S5_GROUPS,), jnp.float32, math.log(S5_DT_MIN), math.log(S5_DT_MAX)),
        'l1_glu_w': nrm((s5w, s5w), s5w ** -0.5),
        'l1_glu_b': nrm((s5w,), 0.01),
        'l1_w_out': nrm((MIX1, D_MODEL), DEEPNORM_BETA * MIX1 ** -0.5),
        'l1_ln1_g': gain(D_MODEL),
        'l1_ln1_b': nrm((D_MODEL,), 0.01),
        'l1_mlp_w1': nrm((D_MODEL, D_FF), D_MODEL ** -0.5),
        'l1_mlp_w2': nrm((D_FF, D_MODEL), DEEPNORM_BETA * D_FF ** -0.5),
        'l1_ln2_g': gain(D_MODEL),
        'l1_ln2_b': nrm((D_MODEL,), 0.01),
    }


def reference(x, positions,
              l0_w_in, l0_gla_wg2, l0_gla_bg, l0_gla_norm, l0_mla_q_norm, l0_mla_w_uq, l0_mla_kv_norm, l0_mla_w_ukv, l0_w_out,
              l0_ln1_g, l0_ln1_b, l0_mlp_w1, l0_mlp_w2, l0_ln2_g, l0_ln2_b,
              l1_w_in, l1_s5_a_re, l1_s5_a_im, l1_s5_b_re, l1_s5_b_im, l1_s5_c_re, l1_s5_c_im, l1_s5_d, l1_s5_log_step,
              l1_glu_w, l1_glu_b, l1_w_out,
              l1_ln1_g, l1_ln1_b, l1_mlp_w1, l1_mlp_w2, l1_ln2_g, l1_ln2_b):
    mixer_params = (
        (l0_w_in, l0_gla_wg2, l0_gla_bg, l0_gla_norm, l0_mla_q_norm, l0_mla_w_uq, l0_mla_kv_norm, l0_mla_w_ukv, l0_w_out),
        (l1_w_in, l1_s5_a_re, l1_s5_a_im, l1_s5_b_re, l1_s5_b_im, l1_s5_c_re, l1_s5_c_im, l1_s5_d, l1_s5_log_step, l1_glu_w, l1_glu_b, l1_w_out),
    )
    ffn_params = (
        (l0_ln1_g, l0_ln1_b, l0_mlp_w1, l0_mlp_w2, l0_ln2_g, l0_ln2_b),
        (l1_ln1_g, l1_ln1_b, l1_mlp_w1, l1_mlp_w2, l1_ln2_g, l1_ln2_b),
    )
    for i in range(DEPTH):
        ln1_g, ln1_b, w1, w2, ln2_g, ln2_b = ffn_params[i]
        if i % 2 == 0:
            mix = _mixer_gla_mla(x, positions, *mixer_params[i])
        else:
            mix = _mixer_dsa_s5(x, *mixer_params[i])
        x = _layernorm(DEEPNORM_ALPHA * x + mix, ln1_g, ln1_b)
        x = _layernorm(DEEPNORM_ALPHA * x + _sq_relu_mlp(x, w1, w2), ln2_g, ln2_b)
    return x
```

```cpp
#include <hip/hip_runtime.h>
#include <hip/hip_cooperative_groups.h>
#include <cstdio>
#include <cstdint>
namespace cg = cooperative_groups;

#define DI __device__ __forceinline__
typedef unsigned short bf16_t;
typedef short bf16x8 __attribute__((ext_vector_type(8)));
typedef short s16x4 __attribute__((ext_vector_type(4)));
typedef float f32x4 __attribute__((ext_vector_type(4)));
typedef float f32x16 __attribute__((ext_vector_type(16)));
typedef unsigned long long u64;

constexpr int NTOK = 32768, SEQ = 8192, DM = 1024;
constexpr size_t MiB = (size_t)1 << 20;
constexpr size_t OFF_WT_IN0 = 0, OFF_WT_OUT0 = 4 * MiB, OFF_WT_10 = 6 * MiB, OFF_WT_20 = 14 * MiB, OFF_WT_IN1 = 22 * MiB,
                 OFF_WT_OUT1 = 28 * MiB, OFF_WT_11 = 30 * MiB, OFF_WT_21 = 38 * MiB, OFF_WT_UQ = 46 * MiB,
                 OFF_WT_UKV = 46 * MiB + 512 * 1024, OFF_WT_GLU = 47 * MiB;
constexpr size_t OFF_XB = 56 * MiB, OFF_XF = 120 * MiB, OFF_BIG = 248 * MiB, OFF_MISC = 504 * MiB;
constexpr size_t OFF_H0 = OFF_BIG, OFF_Q0 = OFF_XF, OFF_K0 = OFF_XF + 48 * MiB, OFF_VT0 = OFF_XF + 96 * MiB;
constexpr size_t OFF_DECAY = OFF_MISC, OFF_APOW = OFF_MISC + 1 * MiB, OFF_BBAR = OFF_MISC + 2 * MiB, OFF_KTAB = OFF_MISC + 3 * MiB,
                 OFF_WI = OFF_MISC + 4 * MiB;
constexpr size_t OFF_H1 = OFF_BIG, OFF_MASK = OFF_BIG + 168 * MiB, OFF_VT1 = OFF_BIG + 200 * MiB, OFF_XEND = OFF_BIG + 232 * MiB;
constexpr size_t OFF_YACT = OFF_XF, OFF_HMID = OFF_BIG;
constexpr size_t OUT_CKV = 0, OUT_OMIX0 = 64 * MiB, OUT_OMIX1 = 0, OUT_UG = 64 * MiB, OUT_TF = 104 * MiB, OUT_E = 124 * MiB;

constexpr int LD_H0 = 2048, LD_H1 = 2688;
constexpr float ALPHA = 1.4142135623730951f;
constexpr float LN_EPS = 1e-5f;

__constant__ float INV_FREQ[16] = {1.0f, 0.5623413324356079f, 0.3162277638912201f, 0.17782793939113617f, 0.10000000149011612f,
  0.05623413249850273f, 0.03162277489900589f, 0.017782794311642647f, 0.009999999776482582f, 0.005623413249850273f,
  0.003162277629598975f, 0.0017782794311642647f, 0.0010000000474974513f, 0.000562341301701963f, 0.0003162277571391314f,
  0.00017782794020604342f};

struct Params {
  const float* in[35];
  float* out;
  char* ws;
  int ph_lo, ph_hi;
  unsigned dup; int pad_;
};

DI bf16_t f2bf(float x) { unsigned u = __float_as_uint(x); u += 0x7fffu + ((u >> 16) & 1u); return (bf16_t)(u >> 16); }
DI float bf2f(bf16_t b) { return __uint_as_float(((unsigned)b) << 16); }
DI unsigned pack2(float a, float b) { unsigned r; asm("v_cvt_pk_bf16_f32 %0, %1, %2" : "=v"(r) : "v"(a), "v"(b)); return r; }
DI uint2 pack4(f32x4 v) { uint2 r; r.x = pack2(v[0], v[1]); r.y = pack2(v[2], v[3]); return r; }
DI float lo_bf(unsigned u) { return __uint_as_float(u << 16); }
DI float hi_bf(unsigned u) { return __uint_as_float(u & 0xffff0000u); }
#define MFMA16(a, b, c) __builtin_amdgcn_mfma_f32_16x16x32_bf16((a), (b), (c), 0, 0, 0)
#define MFMA32(a, b, c) __builtin_amdgcn_mfma_f32_32x32x16_bf16((a), (b), (c), 0, 0, 0)
DI int crow(int reg, int h) { return (reg & 3) + 8 * (reg >> 2) + 4 * h; }

constexpr int G_RS = 144;
constexpr int G_ABUF = 256 * G_RS, G_BBUF = 128 * G_RS;
constexpr int G_LDS = 2 * G_ABUF + 2 * G_BBUF;
constexpr int LDS_AUX = G_LDS;
constexpr int LDS_TOTAL = 131072 + 4096;

typedef unsigned u32x4 __attribute__((ext_vector_type(4)));
struct Stage { u32x4 a0, a1, a2, a3, b0, b1; };

DI void g_load(Stage& s, const bf16_t* A, int lda, const bf16_t* Bt, int ldb, int m0, int n0, int kt, int tid) {
  const int r = tid >> 3, c = tid & 7;
  const bf16_t* ap = A + (size_t)(m0 + r) * lda + kt * 64 + c * 8;
  s.a0 = *(const u32x4*)(ap); s.a1 = *(const u32x4*)(ap + (size_t)64 * lda); s.a2 = *(const u32x4*)(ap + (size_t)128 * lda); s.a3 = *(const u32x4*)(ap + (size_t)192 * lda);
  const bf16_t* bp = Bt + (size_t)(n0 + r) * ldb + kt * 64 + c * 8;
  s.b0 = *(const u32x4*)(bp); s.b1 = *(const u32x4*)(bp + (size_t)64 * ldb);
}
DI void g_write(const Stage& s, char* sA, char* sB, int tid) {
  const int r = tid >> 3, c = tid & 7;
  char* ap = sA + r * G_RS + c * 16;
  *(u32x4*)(ap) = s.a0; *(u32x4*)(ap + 64 * G_RS) = s.a1; *(u32x4*)(ap + 128 * G_RS) = s.a2; *(u32x4*)(ap + 192 * G_RS) = s.a3;
  char* bp = sB + r * G_RS + c * 16;
  *(u32x4*)(bp) = s.b0; *(u32x4*)(bp + 64 * G_RS) = s.b1;
}
DI void g_compute(f32x4 (&acc)[4][4], const char* sA, const char* sB, int wr, int wc, int fr, int fq) {
#pragma unroll
  for (int ks = 0; ks < 2; ++ks) {
    bf16x8 am[4], bn[4];
#pragma unroll
    for (int mi = 0; mi < 4; ++mi) am[mi] = *(const bf16x8*)(sA + (wr * 64 + mi * 16 + fr) * G_RS + ks * 64 + fq * 16);
#pragma unroll
    for (int ni = 0; ni < 4; ++ni) bn[ni] = *(const bf16x8*)(sB + (wc * 64 + ni * 16 + fr) * G_RS + ks * 64 + fq * 16);
#pragma unroll
    for (int mi = 0; mi < 4; ++mi)
#pragma unroll
      for (int ni = 0; ni < 4; ++ni) acc[mi][ni] = MFMA16(bn[ni], am[mi], acc[mi][ni]);
  }
}

template <class Epi>
DI void gemm_tile(const bf16_t* __restrict__ A, int lda, const bf16_t* __restrict__ Bt, int ldb, int K, int m0, int n0, char* lds, const Epi& epi) {
  const int tid = threadIdx.x, lane = tid & 63, wid = tid >> 6, wr = wid >> 1, wc = wid & 1, fr = lane & 15, fq = lane >> 4;
  char* sA0 = lds; char* sA1 = lds + G_ABUF; char* sB0 = lds + 2 * G_ABUF; char* sB1 = sB0 + G_BBUF;
  f32x4 acc[4][4];
#pragma unroll
  for (int mi = 0; mi < 4; ++mi)
#pragma unroll
    for (int ni = 0; ni < 4; ++ni) acc[mi][ni] = (f32x4){0.f, 0.f, 0.f, 0.f};
  const int nk = K >> 6;
  Stage R0, R1;
  g_load(R0, A, lda, Bt, ldb, m0, n0, 0, tid);
  g_load(R1, A, lda, Bt, ldb, m0, n0, 1, tid);
  g_write(R0, sA0, sB0, tid);
  if (2 < nk) g_load(R0, A, lda, Bt, ldb, m0, n0, 2, tid);
  __syncthreads();
  for (int kt = 0; kt < nk; kt += 2) {
    g_compute(acc, sA0, sB0, wr, wc, fr, fq);
    g_write(R1, sA1, sB1, tid);
    if (kt + 3 < nk) g_load(R1, A, lda, Bt, ldb, m0, n0, kt + 3, tid);
    __syncthreads();
    g_compute(acc, sA1, sB1, wr, wc, fr, fq);
    if (kt + 2 < nk) g_write(R0, sA0, sB0, tid);
    if (kt + 4 < nk) g_load(R0, A, lda, Bt, ldb, m0, n0, kt + 4, tid);
    __syncthreads();
  }
  epi(acc, m0 + wr * 64, n0 + wc * 64, fr, fq);
}

struct EpiBf16 {
  bf16_t* O; int ld;
  DI void operator()(const f32x4 (&acc)[4][4], int mw, int nw, int fr, int fq) const {
#pragma unroll
    for (int mi = 0; mi < 4; ++mi)
#pragma unroll
      for (int ni = 0; ni < 4; ++ni) *(uint2*)(O + (size_t)(mw + mi * 16 + fr) * ld + nw + ni * 16 + fq * 4) = pack4(acc[mi][ni]);
  }
};
struct EpiRelu2 {
  bf16_t* O; int ld;
  DI void operator()(const f32x4 (&acc)[4][4], int mw, int nw, int fr, int fq) const {
#pragma unroll
    for (int mi = 0; mi < 4; ++mi)
#pragma unroll
      for (int ni = 0; ni < 4; ++ni) {
        f32x4 v = acc[mi][ni];
#pragma unroll
        for (int j = 0; j < 4; ++j) { float t = fmaxf(v[j], 0.f); v[j] = t * t; }
        *(uint2*)(O + (size_t)(mw + mi * 16 + fr) * ld + nw + ni * 16 + fq * 4) = pack4(v);
      }
  }
};
struct EpiResid {
  const float* X; float* Y;
  DI void operator()(const f32x4 (&acc)[4][4], int mw, int nw, int fr, int fq) const {
#pragma unroll
    for (int mi = 0; mi < 4; ++mi)
#pragma unroll
      for (int ni = 0; ni < 4; ++ni) {
        size_t o = (size_t)(mw + mi * 16 + fr) * DM + nw + ni * 16 + fq * 4;
        f32x4 x = *(const f32x4*)(X + o);
        *(f32x4*)(Y + o) = x * ALPHA + acc[mi][ni];
      }
  }
};
DI void rope_cs(int pos, int i, float& c, float& s) {
  float a = (float)pos * INV_FREQ[i];
  double rev = (double)a * 0.15915494309189535;
  rev -= rint(rev);
  float r = (float)(rev * 6.283185307179586);
  c = __cosf(r); s = __sinf(r);
}
struct EpiUQ {
  bf16_t* Q; const int* pos; const float* rs; int m0;
  DI void operator()(const f32x4 (&acc)[4][4], int mw, int nw, int fr, int fq) const {
    const int c0 = nw % 96;
    const int rope_ni = (c0 == 64) ? 0 : (c0 == 32 ? 2 : 4);
#pragma unroll
    for (int mi = 0; mi < 4; ++mi) {
      const int row = mw + mi * 16 + fr;
      const float sc = rs[row - m0];
      f32x4 v[4];
#pragma unroll
      for (int ni = 0; ni < 4; ++ni) v[ni] = acc[mi][ni] * sc;
      if (rope_ni < 4) {
        const int ps = pos[row];
#pragma unroll
        for (int j = 0; j < 4; ++j) {
          float c, s; rope_cs(ps, fq * 4 + j, c, s);
          if (rope_ni == 0) { float t1 = v[0][j], t2 = v[1][j]; v[0][j] = t1 * c - t2 * s; v[1][j] = t2 * c + t1 * s; }
          else { float t1 = v[2][j], t2 = v[3][j]; v[2][j] = t1 * c - t2 * s; v[3][j] = t2 * c + t1 * s; }
        }
      }
#pragma unroll
      for (int ni = 0; ni < 4; ++ni) *(uint2*)(Q + (size_t)row * 768 + nw + ni * 16 + fq * 4) = pack4(v[ni]);
    }
  }
};
struct EpiUKV {
  bf16_t* Kb; bf16_t* VT; const float* rs; int m0;
  DI void operator()(const f32x4 (&acc)[4][4], int mw, int nw, int fr, int fq) const {
    const int h = nw >> 7; const bool isv = (nw & 64) != 0;
#pragma unroll
    for (int mi = 0; mi < 4; ++mi) {
      const int row = mw + mi * 16 + fr;
      const float sc = rs[row - m0];
      const int b = row >> 13, l = row & 8191;
#pragma unroll
      for (int ni = 0; ni < 4; ++ni) {
        f32x4 v = acc[mi][ni] * sc;
        if (!isv) *(uint2*)(Kb + (size_t)row * 768 + h * 96 + ni * 16 + fq * 4) = pack4(v);
        else {
#pragma unroll
          for (int j = 0; j < 4; ++j) VT[((size_t)((b * 8 + h) * 64 + ni * 16 + fq * 4 + j)) * SEQ + l] = f2bf(v[j]);
        }
      }
    }
  }
};
struct EpiH1 {
  bf16_t* H1; bf16_t* VT; float* WI; bf16_t* Ug;
  DI void operator()(const f32x4 (&acc)[4][4], int mw, int nw, int fr, int fq) const {
#pragma unroll
    for (int mi = 0; mi < 4; ++mi) {
      const int row = mw + mi * 16 + fr;
      const int b = row >> 13, l = row & 8191;
#pragma unroll
      for (int ni = 0; ni < 4; ++ni) {
        const int col = nw + ni * 16 + fq * 4;
        const f32x4 v = acc[mi][ni];
        if (col < 1024 || (col >= 1536 && col < 2112)) *(uint2*)(H1 + (size_t)row * LD_H1 + col) = pack4(v);
        else if (col < 1536) {
          const int hc = col - 1024, h = hc >> 6, e = hc & 63;
#pragma unroll
          for (int j = 0; j < 4; ++j) VT[((size_t)((b * 8 + h) * 64 + e + j)) * SEQ + l] = f2bf(v[j]);
        } else if (col < 2120) {
          *(f32x4*)(WI + (size_t)row * 8 + (col - 2112)) = v * 0.35355339059327373f;
        } else if (col < 2632) {
          const int ch = col - 2120, g = ch >> 4, ci = ch & 15;
          *(uint2*)(Ug + ((size_t)(g * 1024 + (row >> 5))) * 640 + (row & 31) * 16 + ci) = pack4(v);
        }
      }
    }
  }
};
struct EpiF32 {
  float* O; int ld;
  DI void operator()(const f32x4 (&acc)[4][4], int mw, int nw, int fr, int fq) const {
#pragma unroll
    for (int mi = 0; mi < 4; ++mi)
#pragma unroll
      for (int ni = 0; ni < 4; ++ni) *(f32x4*)(O + (size_t)(mw + mi * 16 + fr) * ld + nw + ni * 16 + fq * 4) = acc[mi][ni];
  }
};
DI float gelu_tanh(float x) {
  float u = 0.7978845608028654f * (x + 0.044715f * x * x * x);
  float t = 1.f - 2.f / (__expf(2.f * u) + 1.f);
  return 0.5f * x * (1.f + t);
}
struct EpiS5Y {
  const bf16_t* Ug; const float* D; bf16_t* Y; int g;
  DI void operator()(const f32x4 (&acc)[4][4], int mw, int nw, int fr, int fq) const {
#pragma unroll
    for (int mi = 0; mi < 4; ++mi) {
      const int bc = mw + mi * 16 + fr;
#pragma unroll
      for (int ni = 0; ni < 4; ++ni) {
        const int col = nw + ni * 16 + fq * 4, i = col >> 4, co = col & 15;
        const uint2 uu = *(const uint2*)(Ug + ((size_t)(g * 1024 + bc)) * 640 + col);
        const f32x4 d = *(const f32x4*)(D + g * 16 + co);
        f32x4 v = acc[mi][ni];
        v[0] = gelu_tanh(v[0] + d[0] * lo_bf(uu.x)); v[1] = gelu_tanh(v[1] + d[1] * hi_bf(uu.x));
        v[2] = gelu_tanh(v[2] + d[2] * lo_bf(uu.y)); v[3] = gelu_tanh(v[3] + d[3] * hi_bf(uu.y));
        *(uint2*)(Y + ((size_t)(bc * 32 + i)) * 512 + g * 16 + co) = pack4(v);
      }
    }
  }
};
struct EpiGLU {
  const bf16_t* Y; const float* bias; bf16_t* O;
  DI void operator()(const f32x4 (&acc)[4][4], int mw, int nw, int fr, int fq) const {
#pragma unroll
    for (int mi = 0; mi < 4; ++mi) {
      const int row = mw + mi * 16 + fr;
#pragma unroll
      for (int ni = 0; ni < 4; ++ni) {
        const int col = nw + ni * 16 + fq * 4;
        const uint2 yy = *(const uint2*)(Y + (size_t)row * 512 + col);
        const f32x4 bb = *(const f32x4*)(bias + col);
        f32x4 v = acc[mi][ni] + bb;
        v[0] = lo_bf(yy.x) / (1.f + __expf(-v[0])); v[1] = hi_bf(yy.x) / (1.f + __expf(-v[1]));
        v[2] = lo_bf(yy.y) / (1.f + __expf(-v[2])); v[3] = hi_bf(yy.y) / (1.f + __expf(-v[3]));
        *(uint2*)(O + (size_t)row * 1024 + 512 + col) = pack4(v);
      }
    }
  }
};

namespace pg8 {
#define PG8_LAS __attribute__((address_space(3)))
typedef unsigned short bf16_t;
typedef short bf16x8 __attribute__((ext_vector_type(8)));
typedef float f32x4 __attribute__((ext_vector_type(4)));
typedef unsigned u32x4 __attribute__((ext_vector_type(4)));
constexpr int BM = 256, BK = 64, HALF = 128, HTB = HALF * BK * 2  , STAGE_BYTES = 8 * HTB, NXCD = 8, WGM = 8;

__host__ __device__ __forceinline__ int lds_byte(int r, int c) { const int st = (r >> 4) * 2 + (c >> 5), rr = r & 15, cc = c & 31, ob = rr * 64 + cc * 2; return st * 1024 + (ob ^ (((ob >> 9) & 1) << 5)); }
__host__ __device__ __forceinline__ void stage_rc(int b, int& R, int& C) { const int st = b / 1024, sb = b % 1024, swz = sb ^ (((sb >> 9) & 1) << 5); R = (st >> 1) * 16 + swz / 64; C = (st & 1) * 32 + (swz % 64) / 2; }
__host__ __device__ __forceinline__ int perm32(int rho) { const int n = rho >> 4, i = rho & 15; return 8 * (i >> 2) + 4 * n + (i & 3); }

struct Unit { int pm, pn; };
struct Gemm { const bf16_t* A; const bf16_t* Bt; int M, N, K; };
struct StaticOrder {
    int nM, nN, nwg, G, c;
    __host__ __device__ void init(int M, int N, int G_, int c_) { nM = M / BM; nN = N / BM; nwg = nM * nN; G = G_; c = c_; }
    __host__ __device__ bool next(int i, Unit& u) const {
        const long L = (long)i * G + c; if (L >= nwg) return false;
        int wgid = (int)L; { const int q = nwg / NXCD, r = nwg % NXCD, xcd = wgid % NXCD, off = wgid / NXCD; wgid = (xcd < r ? xcd * (q + 1) : r * (q + 1) + (xcd - r) * q) + off; }
        const int nig = WGM * nN, gid = wgid / nig, fm = gid * WGM, gsz = (nM - fm) < WGM ? (nM - fm) : WGM;
        u.pm = fm + ((wgid % nig) % gsz); u.pn = (wgid % nig) / gsz; return true;
    }
    __device__ __forceinline__ void a_ready(const Unit&) const {}
    __device__ __forceinline__ void done(const Unit&) const {}
};

template <class Epi, class Sched, bool ALIGN_EPI = false, bool SP2 = false>
__device__ __forceinline__ void gemm_phase(PG8_LAS unsigned char* lds, const Gemm g, const Sched& S, const Epi& E) {
    const int tid = threadIdx.x, wid = __builtin_amdgcn_readfirstlane(tid >> 6), lane = tid & 63, wr = wid >> 2, wc = wid & 3, fr = lane & 15, fq = lane >> 4;
    const int K = g.K, nt = K / BK;
    unsigned voffA[2], voffB[2];
#pragma unroll
    for (int i = 0; i < 2; ++i) { int R, C; stage_rc(tid * 16 + i * 8192, R, C); const int Rb = Epi::PERM ? ((R & ~31) + perm32(R & 31)) : R;
        voffA[i] = (unsigned)(R * K + C) * 2u; voffB[i] = (unsigned)(Rb * K + C) * 2u; }
    const size_t kstep = (size_t)(BK * 2);
    const size_t hstep = (size_t)HALF * K * 2;
    const size_t tstep = 2 * hstep;
    const unsigned ldsw = (unsigned)wid * 1024u;
    const int aoff = lds_byte(wr * 64 + fr, fq * 8), boff = lds_byte(wc * 32 + fr, fq * 8);
#define PG8_SA(b, h) (((b) * 2 + (h)) * HTB)
#define PG8_SB(b, h) ((4 + (b) * 2 + (h)) * HTB)
#define PG8_STAGE(bufoff, gbase, voff) do { _Pragma("unroll") for (int _i = 0; _i < 2; ++_i) \
        __builtin_amdgcn_global_load_lds((const unsigned*)((const char*)(gbase) + (voff)[_i]), (PG8_LAS unsigned*)(lds + (bufoff) + ldsw + _i * 8192), 16, 0, 0); } while (0)
#define PG8_LDA(dst, b, h) do { _Pragma("unroll") for (int m = 0; m < 4; ++m) _Pragma("unroll") for (int k = 0; k < 2; ++k) dst[m][k] = *(const PG8_LAS bf16x8*)(lds + PG8_SA(b, h) + aoff + m * 2048 + k * 1024); } while (0)
#define PG8_LDB(dst, b, h) do { _Pragma("unroll") for (int n = 0; n < 2; ++n) _Pragma("unroll") for (int k = 0; k < 2; ++k) dst[n][k] = *(const PG8_LAS bf16x8*)(lds + PG8_SB(b, h) + boff + n * 2048 + k * 1024); } while (0)
#define PG8_MMA(ai, bj, At, Bt) do { __builtin_amdgcn_s_setprio(1); _Pragma("unroll") for (int m = 0; m < 4; ++m) _Pragma("unroll") for (int n = 0; n < 2; ++n) _Pragma("unroll") for (int k = 0; k < 2; ++k) \
        acc[ai][bj][m][n] = __builtin_amdgcn_mfma_f32_16x16x32_bf16(Bt[n][k], At[m][k], acc[ai][bj][m][n], 0, 0, 0); __builtin_amdgcn_s_setprio(0); } while (0)
#define PG8_WAIT_V(n) asm volatile("s_waitcnt vmcnt(" #n ")" ::: "memory")
#define PG8_WAIT_L(n) asm volatile("s_waitcnt lgkmcnt(" #n ")" ::: "memory")
#define PG8_BAR __builtin_amdgcn_s_barrier()
#define PG8_SCHED __builtin_amdgcn_sched_barrier(0)
    Unit cur, nxt; int ui = 0;
    if (!S.next(0, cur)) return;
    f32x4 acc[2][2][4][2];
#pragma unroll
    for (int a = 0; a < 2; ++a)
#pragma unroll
        for (int b = 0; b < 2; ++b)
#pragma unroll
            for (int m = 0; m < 4; ++m)
#pragma unroll
                for (int n = 0; n < 2; ++n) acc[a][b][m][n] = (f32x4){0.f, 0.f, 0.f, 0.f};
    bf16x8 At[4][2], B0[2][2], B1[2][2];
    const char* cA = (const char*)g.A + (size_t)cur.pm * tstep; const char* cB = (const char*)g.Bt + (size_t)cur.pn * tstep;
    S.a_ready(cur);
    if constexpr (SP2) {
        PG8_STAGE(PG8_SB(0, 0), cB, voffB); PG8_STAGE(PG8_SB(0, 1), cB + hstep, voffB); PG8_STAGE(PG8_SA(0, 0), cA, voffA); PG8_STAGE(PG8_SA(0, 1), cA + hstep, voffA);
        if (wr == 1) PG8_BAR;
        PG8_WAIT_V(2); PG8_BAR;
        PG8_STAGE(PG8_SB(1, 0), cB + kstep, voffB); PG8_STAGE(PG8_SA(1, 0), cA + kstep, voffA); PG8_STAGE(PG8_SB(1, 1), cB + hstep + kstep, voffB);
        PG8_WAIT_V(6); PG8_BAR;
    } else {
        PG8_STAGE(PG8_SB(0, 0), cB, voffB); PG8_STAGE(PG8_SA(0, 0), cA, voffA); PG8_STAGE(PG8_SB(0, 1), cB + hstep, voffB); PG8_STAGE(PG8_SA(0, 1), cA + hstep, voffA);
        if (wr == 1) PG8_BAR;
        PG8_WAIT_V(4); PG8_BAR;
        PG8_STAGE(PG8_SB(1, 0), cB + kstep, voffB); PG8_STAGE(PG8_SA(1, 0), cA + kstep, voffA); PG8_STAGE(PG8_SB(1, 1), cB + hstep + kstep, voffB);
        PG8_WAIT_V(6); PG8_BAR;
    }
    for (;;) {
        const bool has_next = S.next(ui + 1, nxt);
        const char* nA = has_next ? (const char*)g.A + (size_t)nxt.pm * tstep : cA; const char* nB = has_next ? (const char*)g.Bt + (size_t)nxt.pn * tstep : cB;
        for (int t = 0; t < nt; t += 2) {
            const bool last = (t == nt - 2);
            const char* a1 = cA + (size_t)(t + 1) * kstep;
            const char* a2 = last ? nA : cA + (size_t)(t + 2) * kstep; const char* b2 = last ? nB : cB + (size_t)(t + 2) * kstep;
            const char* a3 = a2 + kstep; const char* b3 = b2 + kstep;
            if (last && has_next) S.a_ready(nxt);
            if constexpr (SP2) {
            PG8_LDB(B0, 0, 0); PG8_LDB(B1, 0, 1); PG8_SCHED; PG8_LDA(At, 0, 0); PG8_STAGE(PG8_SA(1, 1), a1 + hstep, voffA);
            PG8_WAIT_V(8); PG8_WAIT_L(0); PG8_BAR; PG8_MMA(0, 0, At, B0); PG8_MMA(0, 1, At, B1); PG8_BAR; PG8_SCHED;
            PG8_LDA(At, 0, 1); PG8_STAGE(PG8_SB(0, 0), b2, voffB); PG8_STAGE(PG8_SB(0, 1), b2 + hstep, voffB); PG8_STAGE(PG8_SA(0, 0), a2, voffA);
            PG8_WAIT_V(8); PG8_WAIT_L(0); PG8_BAR; PG8_MMA(1, 0, At, B0); PG8_MMA(1, 1, At, B1); PG8_BAR; PG8_SCHED;
            PG8_LDB(B0, 1, 0); PG8_LDB(B1, 1, 1); PG8_SCHED; PG8_LDA(At, 1, 0); PG8_STAGE(PG8_SA(0, 1), a2 + hstep, voffA);
            PG8_WAIT_V(8); PG8_WAIT_L(0); PG8_BAR; PG8_MMA(0, 0, At, B0); PG8_MMA(0, 1, At, B1); PG8_BAR; PG8_SCHED;
            PG8_LDA(At, 1, 1); PG8_STAGE(PG8_SB(1, 0), b3, voffB); PG8_STAGE(PG8_SB(1, 1), b3 + hstep, voffB); PG8_STAGE(PG8_SA(1, 0), a3, voffA);
            PG8_WAIT_V(8); PG8_WAIT_L(0); PG8_BAR; PG8_MMA(1, 0, At, B0); PG8_MMA(1, 1, At, B1); PG8_BAR; PG8_SCHED;
            } else {
            PG8_LDB(B0, 0, 0); PG8_SCHED; PG8_LDA(At, 0, 0); PG8_STAGE(PG8_SA(1, 1), a1 + hstep, voffA);
            PG8_WAIT_L(8); PG8_BAR; PG8_WAIT_L(0); PG8_MMA(0, 0, At, B0); PG8_BAR; PG8_SCHED;
            PG8_LDB(B1, 0, 1); PG8_STAGE(PG8_SB(0, 0), b2, voffB);
            PG8_BAR; PG8_WAIT_L(0); PG8_MMA(0, 1, At, B1); PG8_BAR;
            PG8_LDA(At, 0, 1); PG8_STAGE(PG8_SA(0, 0), a2, voffA);
            PG8_BAR; PG8_WAIT_L(0); PG8_MMA(1, 0, At, B0); PG8_BAR; PG8_SCHED;
            PG8_STAGE(PG8_SB(0, 1), b2 + hstep, voffB);
            PG8_WAIT_V(6); PG8_BAR; PG8_MMA(1, 1, At, B1); PG8_BAR;
            PG8_LDB(B0, 1, 0); PG8_SCHED; PG8_LDA(At, 1, 0); PG8_STAGE(PG8_SA(0, 1), a2 + hstep, voffA);
            PG8_WAIT_L(8); PG8_BAR; PG8_WAIT_L(0); PG8_MMA(0, 0, At, B0); PG8_BAR; PG8_SCHED;
            PG8_LDB(B1, 1, 1); PG8_STAGE(PG8_SB(1, 0), b3, voffB);
            PG8_BAR; PG8_WAIT_L(0); PG8_MMA(0, 1, At, B1); PG8_BAR;
            PG8_LDA(At, 1, 1); PG8_STAGE(PG8_SA(1, 0), a3, voffA);
            PG8_BAR; PG8_WAIT_L(0); PG8_MMA(1, 0, At, B0); PG8_BAR; PG8_SCHED;
            PG8_STAGE(PG8_SB(1, 1), b3 + hstep, voffB);
            PG8_WAIT_V(6); PG8_BAR; PG8_MMA(1, 1, At, B1); PG8_BAR;
            }
        }
        if constexpr (ALIGN_EPI) { if (wr == 0) PG8_BAR; }
        if constexpr (!Epi::AFTER_DRAIN) { E(acc, cur, wr, wc, fr, fq); S.done(cur); }
        if (!has_next) break;
#pragma unroll
        for (int a = 0; a < 2; ++a)
#pragma unroll
            for (int b = 0; b < 2; ++b)
#pragma unroll
                for (int m = 0; m < 4; ++m)
#pragma unroll
                    for (int n = 0; n < 2; ++n) acc[a][b][m][n] = (f32x4){0.f, 0.f, 0.f, 0.f};
        cur = nxt; cA = nA; cB = nB; ++ui;
        if constexpr (ALIGN_EPI) { if (wr == 1) PG8_BAR; }
    }
    PG8_WAIT_V(0);
    if constexpr (!ALIGN_EPI) { if (wr == 0) PG8_BAR; }
    PG8_BAR;
    if constexpr (Epi::AFTER_DRAIN) { E.fused(acc, cur, wr, wc, fr, fq, lds, wid, lane); S.done(cur); }
#undef PG8_SA
#undef PG8_SB
#undef PG8_STAGE
#undef PG8_LDA
#undef PG8_LDB
#undef PG8_MMA
#undef PG8_WAIT_V
#undef PG8_WAIT_L
#undef PG8_BAR
#undef PG8_SCHED
}
}

struct ElBf16 { bf16_t* O; int ld; DI void operator()(int row, int col, f32x4 v) const { *(uint2*)(O + (size_t)row * ld + col) = pack4(v); } };
struct ElRelu2 { bf16_t* O; int ld; DI void operator()(int row, int col, f32x4 v) const {
#pragma unroll
  for (int j = 0; j < 4; ++j) { float t = fmaxf(v[j], 0.f); v[j] = t * t; }
  *(uint2*)(O + (size_t)row * ld + col) = pack4(v); } };
struct ElResid { const float* X; float* Y; DI void operator()(int row, int col, f32x4 v) const {
  const size_t o = (size_t)row * DM + col; const f32x4 x = *(const f32x4*)(X + o); *(f32x4*)(Y + o) = x * ALPHA + v; } };
struct ElH1 { bf16_t* H1; bf16_t* VT; float* WI; bf16_t* Ug; DI void operator()(int row, int col, f32x4 v) const {
  if (col < 1024 || (col >= 1536 && col < 2112)) *(uint2*)(H1 + (size_t)row * LD_H1 + col) = pack4(v);
  else if (col < 1536) {
    const int hc = col - 1024, h = hc >> 6, e = hc & 63, b = row >> 13, l = row & 8191;
#pragma unroll
    for (int j = 0; j < 4; ++j) VT[((size_t)((b * 8 + h) * 64 + e + j)) * SEQ + l] = f2bf(v[j]);
  } else if (col < 2120) { *(f32x4*)(WI + (size_t)row * 8 + (col - 2112)) = v * 0.35355339059327373f; }
  else if (col < 2632) { const int ch = col - 2120, g = ch >> 4, ci = ch & 15;
    *(uint2*)(Ug + ((size_t)(g * 1024 + (row >> 5))) * 640 + (row & 31) * 16 + ci) = pack4(v); } } };
template <class El> struct EpiEl {
  El el;
  DI void operator()(const f32x4 (&acc)[4][4], int mw, int nw, int fr, int fq) const {
#pragma unroll
    for (int mi = 0; mi < 4; ++mi)
#pragma unroll
      for (int ni = 0; ni < 4; ++ni) el(mw + mi * 16 + fr, nw + ni * 16 + fq * 4, acc[mi][ni]);
  }
};
template <class El> struct P8El {
  static constexpr bool PERM = false, AFTER_DRAIN = false;
  El el;
  DI void operator()(const f32x4 (&acc)[2][2][4][2], const pg8::Unit& u, int wr, int wc, int fr, int fq) const {
#pragma unroll
    for (int ai = 0; ai < 2; ++ai)
#pragma unroll
      for (int m = 0; m < 4; ++m)
#pragma unroll
        for (int bj = 0; bj < 2; ++bj)
#pragma unroll
          for (int n = 0; n < 2; ++n)
            el(u.pm * 256 + ai * 128 + wr * 64 + m * 16 + fr, u.pn * 256 + bj * 128 + wc * 32 + n * 16 + fq * 4, acc[ai][bj][m][n]);
  }
};

struct El8Bf16 { bf16_t* O; int ld; DI void operator()(int row, int col, f32x4 a, f32x4 b) const {
  uint4 w; w.x = pack2(a[0], a[1]); w.y = pack2(a[2], a[3]); w.z = pack2(b[0], b[1]); w.w = pack2(b[2], b[3]); *(uint4*)(O + (size_t)row * ld + col) = w; } };
struct El8Relu2 { bf16_t* O; int ld; DI void operator()(int row, int col, f32x4 a, f32x4 b) const {
#pragma unroll
  for (int j = 0; j < 4; ++j) { float t = fmaxf(a[j], 0.f); a[j] = t * t; float u = fmaxf(b[j], 0.f); b[j] = u * u; }
  uint4 w; w.x = pack2(a[0], a[1]); w.y = pack2(a[2], a[3]); w.z = pack2(b[0], b[1]); w.w = pack2(b[2], b[3]); *(uint4*)(O + (size_t)row * ld + col) = w; } };
struct El8ResidF { const float* X; float* Y; DI void operator()(int row, int col, f32x4 a, f32x4 b) const {
  const size_t o = (size_t)row * DM + col; const f32x4 x0 = *(const f32x4*)(X + o), x1 = *(const f32x4*)(X + o + 4);
  *(f32x4*)(Y + o) = x0 * ALPHA + a; *(f32x4*)(Y + o + 4) = x1 * ALPHA + b; } };
struct El8ResidB { const bf16_t* X; float* Y; DI void operator()(int row, int col, f32x4 a, f32x4 b) const {
  const size_t o = (size_t)row * DM + col; const uint4 x = *(const uint4*)(X + o);
  const f32x4 x0 = {lo_bf(x.x), hi_bf(x.x), lo_bf(x.y), hi_bf(x.y)}, x1 = {lo_bf(x.z), hi_bf(x.z), lo_bf(x.w), hi_bf(x.w)};
  *(f32x4*)(Y + o) = x0 * ALPHA + a; *(f32x4*)(Y + o + 4) = x1 * ALPHA + b; } };
template <class El> struct P8El8 {
  static constexpr bool PERM = true, AFTER_DRAIN = false;
  El el;
  DI void operator()(const f32x4 (&acc)[2][2][4][2], const pg8::Unit& u, int wr, int wc, int fr, int fq) const {
#pragma unroll
    for (int ai = 0; ai < 2; ++ai)
#pragma unroll
      for (int m = 0; m < 4; ++m)
#pragma unroll
        for (int bj = 0; bj < 2; ++bj)
          el(u.pm * 256 + ai * 128 + wr * 64 + m * 16 + fr, u.pn * 256 + bj * 128 + wc * 32 + fq * 8, acc[ai][bj][m][0], acc[ai][bj][m][1]);
  }
};
template <class El> DI void big_gemm8(char* lds, const bf16_t* A, const bf16_t* Bt, int N, int K, const El& el) {
  pg8::Gemm g{A, Bt, NTOK, N, K}; pg8::StaticOrder S; S.init(NTOK, N, (int)gridDim.x, (int)blockIdx.x);
  P8El8<El> E{el};
  pg8::gemm_phase<P8El8<El>, pg8::StaticOrder, true, true>((PG8_LAS unsigned char*)lds, g, S, E);
  __syncthreads();
}
struct P8H1 {
  static constexpr bool PERM = true, AFTER_DRAIN = false;
  bf16_t* H1; bf16_t* VT;
  DI void operator()(const f32x4 (&acc)[2][2][4][2], const pg8::Unit& u, int wr, int wc, int fr, int fq) const {
    if (u.pn == 4 || u.pn == 5) {
#pragma unroll
      for (int ai = 0; ai < 2; ++ai)
#pragma unroll
        for (int m = 0; m < 4; ++m) {
          const int row = u.pm * 256 + ai * 128 + wr * 64 + m * 16 + fr, b = row >> 13, l = row & 8191;
#pragma unroll
          for (int bj = 0; bj < 2; ++bj) {
            const int hc = (u.pn - 4) * 256 + bj * 128 + wc * 32 + fq * 8, h = hc >> 6, e = hc & 63;
            bf16_t* vp = VT + ((size_t)((b * 8 + h) * 64 + e)) * SEQ + l;
            const f32x4 v0 = acc[ai][bj][m][0], v1 = acc[ai][bj][m][1];
            vp[0] = f2bf(v0[0]); vp[SEQ] = f2bf(v0[1]); vp[2 * SEQ] = f2bf(v0[2]); vp[3 * SEQ] = f2bf(v0[3]);
            vp[4 * SEQ] = f2bf(v1[0]); vp[5 * SEQ] = f2bf(v1[1]); vp[6 * SEQ] = f2bf(v1[2]); vp[7 * SEQ] = f2bf(v1[3]);
          }
        }
    } else {
      El8Bf16 st{H1, LD_H1};
#pragma unroll
      for (int ai = 0; ai < 2; ++ai)
#pragma unroll
        for (int m = 0; m < 4; ++m)
#pragma unroll
          for (int bj = 0; bj < 2; ++bj)
            st(u.pm * 256 + ai * 128 + wr * 64 + m * 16 + fr, u.pn * 256 + bj * 128 + wc * 32 + fq * 8, acc[ai][bj][m][0], acc[ai][bj][m][1]);
    }
  }
};
template <class El> DI void big_gemm(char* lds, const bf16_t* A, const bf16_t* Bt, int N, int K, const El& el) {
  pg8::Gemm g{A, Bt, NTOK, N, K}; pg8::StaticOrder S; S.init(NTOK, N, (int)gridDim.x, (int)blockIdx.x);
  P8El<El> E{el};
  pg8::gemm_phase<P8El<El>, pg8::StaticOrder, true, true>((PG8_LAS unsigned char*)lds, g, S, E);
  __syncthreads();
}
struct TJob { const float* W; const float* sc; bf16_t* Wt; int K, N, k0, n0; };
DI void tjob_decode(const Params& p, int t, TJob& j) {
  char* ws = p.ws; int r = t, nn; j.sc = nullptr;
  if (r < 512) { j.W = p.in[2]; j.K = 1024; j.N = 1968; nn = 32; j.Wt = (bf16_t*)(ws + OFF_WT_IN0); }
  else if ((r -= 512) < 256) { j.W = p.in[10]; j.K = 1024; j.N = 1024; nn = 16; j.Wt = (bf16_t*)(ws + OFF_WT_OUT0); }
  else if ((r -= 256) < 1024) { j.W = p.in[13]; j.K = 1024; j.N = 4096; nn = 64; j.Wt = (bf16_t*)(ws + OFF_WT_10); }
  else if ((r -= 1024) < 1024) { j.W = p.in[14]; j.K = 4096; j.N = 1024; nn = 16; j.Wt = (bf16_t*)(ws + OFF_WT_20); }
  else if ((r -= 1024) < 672) { j.W = p.in[17]; j.K = 1024; j.N = 2632; nn = 42; j.Wt = (bf16_t*)(ws + OFF_WT_IN1); }
  else if ((r -= 672) < 256) { j.W = p.in[28]; j.K = 1024; j.N = 1024; nn = 16; j.Wt = (bf16_t*)(ws + OFF_WT_OUT1); }
  else if ((r -= 256) < 1024) { j.W = p.in[31]; j.K = 1024; j.N = 4096; nn = 64; j.Wt = (bf16_t*)(ws + OFF_WT_11); }
  else if ((r -= 1024) < 1024) { j.W = p.in[32]; j.K = 4096; j.N = 1024; nn = 16; j.Wt = (bf16_t*)(ws + OFF_WT_21); }
  else if ((r -= 1024) < 48) { j.W = p.in[7]; j.K = 256; j.N = 768; nn = 12; j.Wt = (bf16_t*)(ws + OFF_WT_UQ); j.sc = p.in[6]; }
  else if ((r -= 48) < 32) { j.W = p.in[9]; j.K = 128; j.N = 1024; nn = 16; j.Wt = (bf16_t*)(ws + OFF_WT_UKV); j.sc = p.in[8]; }
  else { r -= 32; j.W = p.in[26]; j.K = 512; j.N = 512; nn = 8; j.Wt = (bf16_t*)(ws + OFF_WT_GLU); }
  j.k0 = (r / nn) * 64; j.n0 = (r % nn) * 64;
}
DI void tjob_load(const TJob& j, float (&v)[8]) {
  const int tid = threadIdx.x, jj = tid & 63, i = tid >> 6, n = j.n0 + jj;
#pragma unroll
  for (int rr = 0; rr < 8; ++rr) {
    const int k = j.k0 + i + 8 * rr;
    float x = (n < j.N) ? j.W[(size_t)k * j.N + n] : 0.f;
    if (j.sc) x *= j.sc[k];
    v[rr] = x;
  }
}
DI void tjob_store(const TJob& j, const float (&v)[8], float* tile) {
  const int tid = threadIdx.x, jj = tid & 63, i = tid >> 6;
#pragma unroll
  for (int rr = 0; rr < 8; ++rr) tile[(i + 8 * rr) * 65 + jj] = v[rr];
  __syncthreads();
  const int n = tid >> 3, ks = (tid & 7) * 8;
  uint4 o;
  o.x = pack2(tile[(ks + 0) * 65 + n], tile[(ks + 1) * 65 + n]); o.y = pack2(tile[(ks + 2) * 65 + n], tile[(ks + 3) * 65 + n]);
  o.z = pack2(tile[(ks + 4) * 65 + n], tile[(ks + 5) * 65 + n]); o.w = pack2(tile[(ks + 6) * 65 + n], tile[(ks + 7) * 65 + n]);
  *(uint4*)(j.Wt + (size_t)(j.n0 + n) * j.K + j.k0 + ks) = o;
  __syncthreads();
}

DI void phase_prep(const Params& p, char* lds) {
  float* tile = (float*)lds;
  char* ws = p.ws;
  constexpr int NT = 512 + 256 + 1024 + 1024 + 672 + 256 + 1024 + 1024 + 48 + 32 + 64;
  {
    TJob cur, nxt; float vc[8], vn[8];
    int t = blockIdx.x;
    if (t < NT) { tjob_decode(p, t, cur); tjob_load(cur, vc); }
    for (; t < NT; t += gridDim.x) {
      const bool has = (t + (int)gridDim.x) < NT;
      if (has) { tjob_decode(p, t + gridDim.x, nxt); tjob_load(nxt, vn); }
      tjob_store(cur, vc, tile);
      if (has) {
        cur = nxt;
#pragma unroll
        for (int rr = 0; rr < 8; ++rr) vc[rr] = vn[rr];
      }
    }
  }
  {
    const float* x = p.in[0]; bf16_t* xb = (bf16_t*)(ws + OFF_XB);
    const size_t n4 = (size_t)NTOK * DM / 4, gsz = (size_t)gridDim.x * 512;
    for (size_t i = (size_t)blockIdx.x * 512 + threadIdx.x; i < n4; i += gsz) {
      f32x4 v = *(const f32x4*)(x + i * 4);
      *(uint2*)(xb + i * 4) = pack4(v);
    }
  }
  {
    float* apow = (float*)(ws + OFF_APOW); float* bbar = (float*)(ws + OFF_BBAR);
    const int gsz = gridDim.x * 512, gid = blockIdx.x * 512 + threadIdx.x;
    for (int i = gid; i < 32 * 33 * 64; i += gsz) {
      const int pp = i & 63, tau = (i >> 6) % 33, g = i / (64 * 33);
      const float dt = expf(p.in[25][g]);
      const float lre = fminf(p.in[18][g * 64 + pp], -1e-4f), lim = p.in[19][g * 64 + pp];
      const float mag = expf(lre * dt * (float)tau);
      const double th = (double)(lim * dt) * (double)tau;
      apow[2 * i] = mag * (float)cos(th); apow[2 * i + 1] = mag * (float)sin(th);
    }
    for (int i = gid; i < 32 * 64 * 16; i += gsz) {
      const int ci = i & 15, pp = (i >> 4) & 63, g = i >> 10;
      const float dt = expf(p.in[25][g]);
      const float lre = fminf(p.in[18][g * 64 + pp], -1e-4f), lim = p.in[19][g * 64 + pp];
      const float mag = expf(lre * dt);
      const float are = mag * cosf(lim * dt), aim = mag * sinf(lim * dt);
      const float den = lre * lre + lim * lim, nr = are - 1.f, ni = aim;
      const float cre = (nr * lre + ni * lim) / den, cim = (ni * lre - nr * lim) / den;
      const float bre = p.in[20][i], bim = p.in[21][i];
      bbar[2 * i] = cre * bre - cim * bim; bbar[2 * i + 1] = cre * bim + cim * bre;
    }
  }
}

DI void s5_ktab(const Params& p) {
  const float* apow = (const float*)(p.ws + OFF_APOW); const float* bbar = (const float*)(p.ws + OFF_BBAR);
  float* ktab = (float*)(p.ws + OFF_KTAB);
  const int gsz = gridDim.x * 512, gid = blockIdx.x * 512 + threadIdx.x;
  for (int i = gid; i < 32 * 32 * 256; i += gsz) {
    const int ci = i & 15, co = (i >> 4) & 15, tau = (i >> 8) & 31, g = i >> 13;
    float s = 0.f;
    for (int pp = 0; pp < 64; ++pp) {
      const float cr = p.in[22][(g * 16 + co) * 64 + pp], cim = p.in[23][(g * 16 + co) * 64 + pp];
      const float ar = apow[2 * ((g * 33 + tau) * 64 + pp)], ai = apow[2 * ((g * 33 + tau) * 64 + pp) + 1];
      const float br = bbar[2 * ((g * 64 + pp) * 16 + ci)], bi = bbar[2 * ((g * 64 + pp) * 16 + ci) + 1];
      const float xr = ar * br - ai * bi, xi = ar * bi + ai * br;
      s += cr * xr - cim * xi;
    }
    ktab[i] = s;
  }
}
DI void s5_expand(const Params& p) {
  const float* apow = (const float*)(p.ws + OFF_APOW); const float* bbar = (const float*)(p.ws + OFF_BBAR);
  const float* ktab = (const float*)(p.ws + OFF_KTAB);
  bf16_t* TF = (bf16_t*)((char*)p.out + OUT_TF); bf16_t* E = (bf16_t*)((char*)p.out + OUT_E);
  const int gsz = gridDim.x * 512, gid = blockIdx.x * 512 + threadIdx.x;
#pragma unroll 4
  for (int i = gid; i < 32 * 512 * 640; i += gsz) {
    const int k = i % 640, n = (i / 640) & 511, g = i / (640 * 512);
    const int ii = n >> 4, co = n & 15;
    float v;
    if (k < 512) { const int j = k >> 4, ci = k & 15; v = (j <= ii) ? ktab[((g * 32 + (ii - j)) * 16 + co) * 16 + ci] : 0.f; }
    else {
      const int pp = (k - 512) >> 1, ri = k & 1;
      const float cr = p.in[22][(g * 16 + co) * 64 + pp], cim = p.in[23][(g * 16 + co) * 64 + pp];
      const float ar = apow[2 * ((g * 33 + ii + 1) * 64 + pp)], ai = apow[2 * ((g * 33 + ii + 1) * 64 + pp) + 1];
      v = ri ? -(cr * ai + cim * ar) : (cr * ar - cim * ai);
    }
    TF[i] = f2bf(v);
  }
#pragma unroll 4
  for (int i = gid; i < 32 * 128 * 512; i += gsz) {
    const int k = i & 511, n = (i >> 9) & 127, g = i >> 16;
    const int j = k >> 4, ci = k & 15, pp = n >> 1, ri = n & 1;
    const float ar = apow[2 * ((g * 33 + (31 - j)) * 64 + pp)], ai = apow[2 * ((g * 33 + (31 - j)) * 64 + pp) + 1];
    const float br = bbar[2 * ((g * 64 + pp) * 16 + ci)], bi = bbar[2 * ((g * 64 + pp) * 16 + ci) + 1];
    E[i] = f2bf(ri ? (ar * bi + ai * br) : (ar * br - ai * bi));
  }
}

DI void phase_ln(const float* __restrict__ X, float* __restrict__ Yf, bf16_t* __restrict__ Yb, const float* __restrict__ g, const float* __restrict__ bta) {
  const int lane = threadIdx.x & 63, wid = threadIdx.x >> 6;
  for (int row = blockIdx.x * 8 + wid; row < NTOK; row += gridDim.x * 8) {
    f32x4 v[4]; float s = 0.f;
#pragma unroll
    for (int i = 0; i < 4; ++i) { v[i] = *(const f32x4*)(X + (size_t)row * DM + i * 256 + lane * 4); s += (v[i][0] + v[i][1]) + (v[i][2] + v[i][3]); }
#pragma unroll
    for (int o = 32; o >= 1; o >>= 1) s += __shfl_xor(s, o);
    const float mu = s * (1.f / 1024.f); float q = 0.f;
#pragma unroll
    for (int i = 0; i < 4; ++i) { f32x4 d = v[i] - mu; q += (d[0] * d[0] + d[1] * d[1]) + (d[2] * d[2] + d[3] * d[3]); }
#pragma unroll
    for (int o = 32; o >= 1; o >>= 1) q += __shfl_xor(q, o);
    const float rstd = rsqrtf(q * (1.f / 1024.f) + LN_EPS);
#pragma unroll
    for (int i = 0; i < 4; ++i) {
      const int c = i * 256 + lane * 4;
      f32x4 gg = *(const f32x4*)(g + c), bb = *(const f32x4*)(bta + c);
      f32x4 o = (v[i] - mu) * rstd * gg + bb;
      if (Yf) *(f32x4*)(Yf + (size_t)row * DM + c) = o;
      if (Yb) *(uint2*)(Yb + (size_t)row * DM + c) = pack4(o);
    }
  }
}

DI float xhalf_max(float x) { const auto r = __builtin_amdgcn_permlane32_swap(__float_as_uint(x), __float_as_uint(x), false, false); return fmaxf(__uint_as_float(r[0]), __uint_as_float(r[1])); }
DI float xhalf_sum(float x) { const auto r = __builtin_amdgcn_permlane32_swap(__float_as_uint(x), __float_as_uint(x), false, false); return __uint_as_float(r[0]) + __uint_as_float(r[1]); }
template <int DQ, bool MASKED>
DI void attn_item(const bf16_t* __restrict__ Q, int ldq, const bf16_t* __restrict__ Kp, int ldk, const bf16_t* __restrict__ VT,
                  bf16_t* __restrict__ O, int ocol, const unsigned* __restrict__ mask, int b, int h, int qb, float scale_log2, char* lds) {
  constexpr int KRS = DQ * 2 + 16, VRS = 136, NS = DQ / 16, KP = DQ / 8;
  constexpr int KBUF = 64 * KRS, VBUF = 64 * VRS;
  const int tid = threadIdx.x, lane = tid & 63, w = tid >> 6, c = lane & 31, hh = lane >> 5;
  const int q0 = qb * 256, qw0 = q0 + w * 32;
  const size_t tokbase = (size_t)b * SEQ;
  char* sK0 = lds; char* sK1 = lds + KBUF; char* sV0 = lds + 2 * KBUF; char* sV1 = sV0 + VBUF;
  bf16x8 qf[NS];
#pragma unroll
  for (int s = 0; s < NS; ++s) qf[s] = *(const bf16x8*)(Q + (tokbase + qw0 + c) * ldq + h * DQ + s * 16 + hh * 8);
  const bf16_t* Kbase = Kp + tokbase * ldk + h * DQ;
  const bf16_t* Vbase = VT + (size_t)((b * 8 + h) * 64) * SEQ;
  const int ntiles = (q0 + 256) / 64;
  uint4 rk0, rk1, rv; uint2 rm = {0u, 0u};
  char* sM0 = sV1 + VBUF; char* sM1 = sM0 + 2048;
  const unsigned* mrow = MASKED ? mask + (tokbase + q0 + (tid & 255)) * 256 : nullptr;
  const int kr0 = tid / KP, kc0 = tid % KP, kr1 = (tid + 512) / KP, kc1 = (tid + 512) % KP;
  const bool has1 = (tid + 512) < 64 * KP;
  const int vr = tid >> 3, vc = tid & 7;
  auto gl = [&](int t) {
    rk0 = *(const uint4*)(Kbase + (size_t)(t * 64 + kr0) * ldk + kc0 * 8);
    if (has1) rk1 = *(const uint4*)(Kbase + (size_t)(t * 64 + kr1) * ldk + kc1 * 8);
    rv = *(const uint4*)(Vbase + (size_t)vr * SEQ + t * 64 + vc * 8);
    if (MASKED) { if (tid < 256) rm = *(const uint2*)(mrow + 2 * t); }
  };
  auto sw = [&](char* sK, char* sV) {
    if (MASKED) { if (tid < 256) *(uint2*)((sK == sK0 ? sM0 : sM1) + tid * 8) = rm; }
    *(uint4*)(sK + kr0 * KRS + kc0 * 16) = rk0;
    if (has1) *(uint4*)(sK + kr1 * KRS + kc1 * 16) = rk1;
    *(uint2*)(sV + vr * VRS + vc * 16) = (uint2){rv.x, rv.y};
    *(uint2*)(sV + vr * VRS + vc * 16 + 8) = (uint2){rv.z, rv.w};
  };
  f32x16 oacc[2];
#pragma unroll
  for (int i = 0; i < 16; ++i) { oacc[0][i] = 0.f; oacc[1][i] = 0.f; }
  float mrun = -1e30f, lrun = 0.f;
  gl(0); sw(sK0, sV0);
  if (ntiles > 1) gl(1);
  __syncthreads();
  for (int t = 0; t < ntiles; ++t) {
    char* sK = (t & 1) ? sK1 : sK0; char* sV = (t & 1) ? sV1 : sV0;
    const int kt0 = t * 64;
    if (kt0 <= qw0 + 31) {
      f32x16 sacc[2];
#pragma unroll
      for (int rb = 0; rb < 2; ++rb) {
        bf16x8 kf[NS];
#pragma unroll
        for (int s = 0; s < NS; ++s) kf[s] = *(const bf16x8*)(sK + (rb * 32 + c) * KRS + s * 32 + hh * 16);
        __builtin_amdgcn_sched_barrier(0);
#pragma unroll
        for (int i = 0; i < 16; ++i) sacc[rb][i] = 0.f;
#pragma unroll
        for (int s = 0; s < NS; ++s) sacc[rb] = MFMA32(kf[s], qf[s], sacc[rb]);
      }
      constexpr float NEGM = -3.0e38f;
      if (MASKED) {
        const uint2 mm = *(const uint2*)(((t & 1) ? sM1 : sM0) + (w * 32 + c) * 8);
#pragma unroll
        for (int rb = 0; rb < 2; ++rb)
#pragma unroll
          for (int i = 0; i < 16; ++i) {
            const unsigned mb = (unsigned)__builtin_amdgcn_sbfe((int)(rb ? mm.y : mm.x), crow(i, hh), 1);
            sacc[rb][i] = __uint_as_float((__float_as_uint(sacc[rb][i]) & mb) | (__float_as_uint(NEGM) & ~mb));
          }
      } else if (kt0 + 63 > qw0) {
#pragma unroll
        for (int rb = 0; rb < 2; ++rb)
#pragma unroll
          for (int i = 0; i < 16; ++i) if (kt0 + rb * 32 + crow(i, hh) > qw0 + c) sacc[rb][i] = NEGM;
      }
      float mx = NEGM;
#pragma unroll
      for (int rb = 0; rb < 2; ++rb)
#pragma unroll
        for (int i = 0; i < 16; ++i) mx = fmaxf(mx, sacc[rb][i]);
      mx = xhalf_max(mx);
      const float mnew = fmaxf(mrun, mx * scale_log2);
      if (__any(mnew > mrun)) {
        const float alpha = __builtin_amdgcn_exp2f(mrun - mnew);
        mrun = mnew; lrun *= alpha;
#pragma unroll
        for (int i = 0; i < 16; ++i) { oacc[0][i] *= alpha; oacc[1][i] *= alpha; }
      }
      float ps = 0.f;
#pragma unroll
      for (int rb = 0; rb < 2; ++rb)
#pragma unroll
        for (int i = 0; i < 16; ++i) {
          const float pv = __builtin_amdgcn_exp2f(fmaf(sacc[rb][i], scale_log2, -mrun));
          sacc[rb][i] = pv; ps += pv;
        }
      lrun += ps;
#pragma unroll
      for (int kb = 0; kb < 2; ++kb) {
        bf16x8 va[2][2];
#pragma unroll
        for (int s = 0; s < 2; ++s)
#pragma unroll
          for (int eb = 0; eb < 2; ++eb) {
            const char* vp = sV + (eb * 32 + c) * VRS + (kb * 32 + s * 16 + hh * 4) * 2;
            const s16x4 a0 = *(const s16x4*)vp, a1 = *(const s16x4*)(vp + 16);
            va[s][eb] = __builtin_shufflevector(a0, a1, 0, 1, 2, 3, 4, 5, 6, 7);
          }
#pragma unroll
        for (int s = 0; s < 2; ++s) {
          const unsigned u0 = pack2(sacc[kb][8 * s + 0], sacc[kb][8 * s + 1]), u1 = pack2(sacc[kb][8 * s + 2], sacc[kb][8 * s + 3]);
          const unsigned u2 = pack2(sacc[kb][8 * s + 4], sacc[kb][8 * s + 5]), u3 = pack2(sacc[kb][8 * s + 6], sacc[kb][8 * s + 7]);
          const u32x4 uu = {u0, u1, u2, u3};
          const bf16x8 pb = __builtin_bit_cast(bf16x8, uu);
#pragma unroll
          for (int eb = 0; eb < 2; ++eb) oacc[eb] = MFMA32(va[s][eb], pb, oacc[eb]);
        }
      }
    }
    if (t + 1 < ntiles) sw((t & 1) ? sK0 : sK1, (t & 1) ? sV0 : sV1);
    if (t + 2 < ntiles) gl(t + 2);
    __syncthreads();
  }
  const float ltot = xhalf_sum(lrun);
  const float inv = 1.f / ltot;
  bf16_t* orow = O + (tokbase + qw0 + c) * 1024 + ocol + h * 64;
#pragma unroll
  for (int eb = 0; eb < 2; ++eb)
#pragma unroll
    for (int g4 = 0; g4 < 4; ++g4) {
      f32x4 v = {oacc[eb][4 * g4] * inv, oacc[eb][4 * g4 + 1] * inv, oacc[eb][4 * g4 + 2] * inv, oacc[eb][4 * g4 + 3] * inv};
      *(uint2*)(orow + eb * 32 + 8 * g4 + 4 * hh) = pack4(v);
    }
}

constexpr int GL_CUM = 0;
constexpr int GL_GLR = 16640;
constexpr int GL_SEG = 20736;
constexpr int GL_A = 22784;
constexpr int GL_B = 32000;
constexpr int GL_VT = 41216;
constexpr int GL_SP = 59648;
constexpr int GL_SSQ = 78080;

DI void gla_cum(const Params& p, const bf16_t* H0, int tok0, int h, char* lds) {
  const int tid = threadIdx.x;
  float* cum = (float*)(lds + GL_CUM); float* glr = (float*)(lds + GL_GLR); float* seg = (float*)(lds + GL_SEG);
  for (int i = tid; i < 64 * 16; i += 512) glr[i] = bf2f(H0[(size_t)(tok0 + (i >> 4)) * LD_H0 + 1024 + (i & 15)]);
  __syncthreads();
  {
    const int tok = tid >> 3, d0 = (tid & 7) * 8;
    float g[8];
#pragma unroll
    for (int j = 0; j < 8; ++j) g[j] = p.in[4][h * 64 + d0 + j];
#pragma unroll
    for (int r = 0; r < 16; ++r) {
      const float gv = glr[tok * 16 + r];
      const f32x4 w0 = *(const f32x4*)(p.in[3] + r * 256 + h * 64 + d0), w1 = *(const f32x4*)(p.in[3] + r * 256 + h * 64 + d0 + 4);
#pragma unroll
      for (int j = 0; j < 4; ++j) { g[j] += gv * w0[j]; g[4 + j] += gv * w1[j]; }
    }
#pragma unroll
    for (int j = 0; j < 8; ++j) {
      const float x = g[j];
      const float ls = fminf(x, 0.f) - log1pf(expf(-fabsf(x)));
      cum[tok * 65 + d0 + j] = ls * (1.f / 16.f);
    }
  }
  __syncthreads();
  {
    const int d = tid & 63, sg = tid >> 6;
    float run = 0.f;
#pragma unroll
    for (int j = 0; j < 8; ++j) { run += cum[(sg * 8 + j) * 65 + d]; cum[(sg * 8 + j) * 65 + d] = run; }
    seg[sg * 64 + d] = run;
    __syncthreads();
    float off = 0.f;
    for (int s2 = 0; s2 < sg; ++s2) off += seg[s2 * 64 + d];
#pragma unroll
    for (int j = 0; j < 8; ++j) cum[(sg * 8 + j) * 65 + d] += off;
  }
  __syncthreads();
}

DI void gla_load_vt(const bf16_t* H0, int tok0, int h, char* lds) {
  const int tid = threadIdx.x;
  for (int i = tid; i < 64 * 16; i += 512) {
    const int tok = i >> 4, e0 = (i & 15) * 8;
    const uint4 v = *(const uint4*)(H0 + (size_t)(tok0 + tok) * LD_H0 + 512 + h * 128 + e0);
    bf16_t* vt = (bf16_t*)(lds + GL_VT);
    vt[(e0 + 0) * 72 + tok] = (bf16_t)(v.x & 0xffff); vt[(e0 + 1) * 72 + tok] = (bf16_t)(v.x >> 16);
    vt[(e0 + 2) * 72 + tok] = (bf16_t)(v.y & 0xffff); vt[(e0 + 3) * 72 + tok] = (bf16_t)(v.y >> 16);
    vt[(e0 + 4) * 72 + tok] = (bf16_t)(v.z & 0xffff); vt[(e0 + 5) * 72 + tok] = (bf16_t)(v.z >> 16);
    vt[(e0 + 6) * 72 + tok] = (bf16_t)(v.w & 0xffff); vt[(e0 + 7) * 72 + tok] = (bf16_t)(v.w >> 16);
  }
}

DI void gla_stageA(const Params& p, int item, char* lds) {
  const bf16_t* H0 = (const bf16_t*)(p.ws + OFF_H0);
  float* ckv = (float*)((char*)p.out + OUT_CKV); float* decay = (float*)(p.ws + OFF_DECAY);
  const int b = item >> 9, h = (item >> 7) & 3, n = item & 127;
  const int tok0 = b * SEQ + n * 64;
  const int tid = threadIdx.x, lane = tid & 63, w = tid >> 6, c = lane & 31, hh = lane >> 5;
  gla_cum(p, H0, tok0, h, lds);
  const float* cum = (const float*)(lds + GL_CUM);
  gla_load_vt(H0, tok0, h, lds);
  {
    bf16_t* ke = (bf16_t*)(lds + GL_A);
    for (int i = tid; i < 64 * 64; i += 512) {
      const int tok = i >> 6, d = i & 63;
      const float kv = bf2f(H0[(size_t)(tok0 + tok) * LD_H0 + 256 + h * 64 + d]);
      ke[d * 72 + tok] = f2bf(kv * expf(cum[63 * 65 + d] - cum[tok * 65 + d]));
    }
    if (tid < 64) decay[(size_t)item * 64 + tid] = expf(cum[63 * 65 + tid]);
    {
      float* cg = (float*)(p.ws + OFF_BIG + 128 * MiB) + (size_t)item * 4096;
      for (int i = tid; i < 4096; i += 512) cg[i] = cum[(i >> 6) * 65 + (i & 63)];
    }
  }
  __syncthreads();
  {
    const int db = w & 1, eb = w >> 1;
    f32x16 acc;
#pragma unroll
    for (int i = 0; i < 16; ++i) acc[i] = 0.f;
#pragma unroll
    for (int s = 0; s < 4; ++s) {
      bf16x8 a = *(const bf16x8*)(lds + GL_A + (db * 32 + c) * 144 + s * 32 + hh * 16);
      bf16x8 bb = *(const bf16x8*)(lds + GL_VT + (eb * 32 + c) * 144 + s * 32 + hh * 16);
      acc = MFMA32(a, bb, acc);
    }
#pragma unroll
    for (int i = 0; i < 16; ++i) ckv[(size_t)item * 8192 + (db * 32 + crow(i, hh)) * 128 + eb * 32 + c] = acc[i];
  }
  __syncthreads();
}

DI void gla_scan(const Params& p) {
  float* ckv = (float*)((char*)p.out + OUT_CKV); const float* decay = (const float*)(p.ws + OFF_DECAY);
  for (int e = blockIdx.x * 512 + threadIdx.x; e < 16 * 8192; e += gridDim.x * 512) {
    const int bh = e >> 13, de = e & 8191, d = de >> 7;
    float st = 0.f;
    float* base = ckv + (size_t)bh * 128 * 8192 + de;
    const float* dbase = decay + (size_t)bh * 128 * 64 + d;
    for (int n0 = 0; n0 < 128; n0 += 8) {
      float kv[8], dc[8];
#pragma unroll
      for (int j = 0; j < 8; ++j) { kv[j] = base[(size_t)(n0 + j) * 8192]; dc[j] = dbase[(n0 + j) * 64]; }
#pragma unroll
      for (int j = 0; j < 8; ++j) { base[(size_t)(n0 + j) * 8192] = st; st = dc[j] * st + kv[j]; }
    }
  }
}

DI void gla_stageC(const Params& p, int item, char* lds) {
  const bf16_t* H0 = (const bf16_t*)(p.ws + OFF_H0);
  const float* sprev = (const float*)((const char*)p.out + OUT_CKV);
  bf16_t* Omix = (bf16_t*)((char*)p.out + OUT_OMIX0);
  const int b = item >> 9, h = (item >> 7) & 3, n = item & 127;
  const int tok0 = b * SEQ + n * 64;
  const int tid = threadIdx.x, lane = tid & 63, w = tid >> 6, c = lane & 31, hh = lane >> 5;
  {
    const float* cg = (const float*)(p.ws + OFF_BIG + 128 * MiB) + (size_t)item * 4096;
    float* cw = (float*)(lds + GL_CUM);
    for (int i = tid; i < 4096; i += 512) cw[(i >> 6) * 65 + (i & 63)] = cg[i];
  }
  __syncthreads();
  const float* cum = (const float*)(lds + GL_CUM);
  gla_load_vt(H0, tok0, h, lds);
  {
    bf16_t* qd = (bf16_t*)(lds + GL_A); bf16_t* ki = (bf16_t*)(lds + GL_B);
    for (int i = tid; i < 64 * 64; i += 512) {
      const int tok = i >> 6, d = i & 63;
      const float cv = cum[tok * 65 + d];
      const float qv = bf2f(H0[(size_t)(tok0 + tok) * LD_H0 + h * 64 + d]);
      const float kv = bf2f(H0[(size_t)(tok0 + tok) * LD_H0 + 256 + h * 64 + d]);
      qd[tok * 72 + d] = f2bf(qv * 0.125f * expf(cv));
      ki[tok * 72 + d] = f2bf(kv * expf(-cv));
    }
    bf16_t* sp = (bf16_t*)(lds + GL_SP);
    for (int i = tid; i < 64 * 128; i += 512) {
      const int d = i >> 7, e = i & 127;
      sp[e * 72 + d] = f2bf(sprev[(size_t)item * 8192 + i]);
    }
  }
  __syncthreads();
  const int ib = w & 1, eh = w >> 1;
  f32x16 o;
#pragma unroll
  for (int i = 0; i < 16; ++i) o[i] = 0.f;
  {
    f32x16 at[2];
#pragma unroll
    for (int rb = 0; rb < 2; ++rb) {
#pragma unroll
      for (int i = 0; i < 16; ++i) at[rb][i] = 0.f;
#pragma unroll
      for (int s = 0; s < 4; ++s) {
        bf16x8 a = *(const bf16x8*)(lds + GL_B + (rb * 32 + c) * 144 + s * 32 + hh * 16);
        bf16x8 bq = *(const bf16x8*)(lds + GL_A + (ib * 32 + c) * 144 + s * 32 + hh * 16);
        at[rb] = MFMA32(a, bq, at[rb]);
      }
#pragma unroll
      for (int i = 0; i < 16; ++i) if (rb * 32 + crow(i, hh) > ib * 32 + c) at[rb][i] = 0.f;
    }
#pragma unroll
    for (int kb = 0; kb < 2; ++kb)
#pragma unroll
      for (int s = 0; s < 2; ++s) {
        unsigned u0 = pack2(at[kb][8 * s + 0], at[kb][8 * s + 1]), u1 = pack2(at[kb][8 * s + 2], at[kb][8 * s + 3]);
        unsigned u2 = pack2(at[kb][8 * s + 4], at[kb][8 * s + 5]), u3 = pack2(at[kb][8 * s + 6], at[kb][8 * s + 7]);
        uint4 uu = {u0, u1, u2, u3};
        const char* vp = lds + GL_VT + (eh * 32 + c) * 144 + (kb * 32 + s * 16 + hh * 4) * 2;
        uint2 a0 = *(const uint2*)vp, a1 = *(const uint2*)(vp + 16);
        uint4 aa = {a0.x, a0.y, a1.x, a1.y};
        o = MFMA32(__builtin_bit_cast(bf16x8, aa), __builtin_bit_cast(bf16x8, uu), o);
      }
#pragma unroll
    for (int s = 0; s < 4; ++s) {
      bf16x8 a = *(const bf16x8*)(lds + GL_SP + (eh * 32 + c) * 144 + s * 32 + hh * 16);
      bf16x8 bq = *(const bf16x8*)(lds + GL_A + (ib * 32 + c) * 144 + s * 32 + hh * 16);
      o = MFMA32(a, bq, o);
    }
  }
  float ss = 0.f;
#pragma unroll
  for (int i = 0; i < 16; ++i) ss += o[i] * o[i];
  ss += __shfl_xor(ss, 32);
  float* ssq = (float*)(lds + GL_SSQ);
  if (hh == 0) ssq[(ib * 4 + eh) * 32 + c] = ss;
  __syncthreads();
  const float tot = ssq[(ib * 4 + 0) * 32 + c] + ssq[(ib * 4 + 1) * 32 + c] + ssq[(ib * 4 + 2) * 32 + c] + ssq[(ib * 4 + 3) * 32 + c];
  const float rn = rsqrtf(tot * (1.f / 128.f) + LN_EPS);
  const size_t tok = (size_t)tok0 + ib * 32 + c;
#pragma unroll
  for (int g4 = 0; g4 < 4; ++g4) {
    const int e = eh * 32 + 8 * g4 + 4 * hh;
    const uint2 rr = *(const uint2*)(H0 + tok * LD_H0 + 1040 + h * 128 + e);
    const f32x4 gn = *(const f32x4*)(p.in[5] + h * 128 + e);
    float r0 = lo_bf(rr.x), r1 = hi_bf(rr.x), r2 = lo_bf(rr.y), r3 = hi_bf(rr.y);
    f32x4 v;
    v[0] = o[4 * g4 + 0] * rn * gn[0] * (r0 / (1.f + __expf(-r0)));
    v[1] = o[4 * g4 + 1] * rn * gn[1] * (r1 / (1.f + __expf(-r1)));
    v[2] = o[4 * g4 + 2] * rn * gn[2] * (r2 / (1.f + __expf(-r2)));
    v[3] = o[4 * g4 + 3] * rn * gn[3] * (r3 / (1.f + __expf(-r3)));
    *(uint2*)(Omix + tok * 1024 + h * 128 + e) = pack4(v);
  }
  __syncthreads();
}

DI unsigned okey(float s) { s += 0.f; unsigned u = __float_as_uint(s); return (u & 0x80000000u) ? ~u : (u | 0x80000000u); }

template <int NI>
DI void idx_count(const unsigned (&k0)[NI], const unsigned (&k1)[NI], unsigned ca, unsigned cb, int mode, unsigned pa, unsigned pb, int w, int c,
                  int hh, unsigned* part, unsigned (&tot)[4]) {
  unsigned na = 0, nb = 0;
  const int da = w * 32 + c - (int)pa, db = w * 32 + c - (int)pb;
  if (mode == 0) {
#pragma unroll
    for (int i = 0; i < NI; ++i) { na += (k0[i] >= ca) ? 1u : 0u; nb += (k1[i] >= cb) ? 1u : 0u; }
  } else {
#pragma unroll
    for (int i = 0; i < NI; ++i) {
      na += (k0[i] == ca && da < -256 * i) ? 1u : 0u; nb += (k1[i] == cb && db < -256 * i) ? 1u : 0u;
    }
  }
#pragma unroll
  for (int o = 16; o >= 1; o >>= 1) { na += __shfl_xor(na, o); nb += __shfl_xor(nb, o); }
  if (c == 0) { part[w * 4 + 2 * hh] = na; part[w * 4 + 2 * hh + 1] = nb; }
  __syncthreads();
#pragma unroll
  for (int q = 0; q < 4; ++q) tot[q] = 0;
#pragma unroll
  for (int ww = 0; ww < 8; ++ww) {
    const uint4 v = *(const uint4*)(part + ww * 4);
    tot[0] += v.x; tot[1] += v.y; tot[2] += v.z; tot[3] += v.w;
  }
}

template <int NI>
DI void idx_item_t(const Params& p, int b, int t0, char* lds) {
  const bf16_t* H1 = (const bf16_t*)(p.ws + OFF_H1);
  const float* WI = (const float*)(p.ws + OFF_WI);
  unsigned* mask = (unsigned*)(p.ws + OFF_MASK);
  const size_t tb = (size_t)b * SEQ;
  int tid = threadIdx.x;
  asm volatile("" : "+v"(tid));
  const int lane = tid & 63, w = __builtin_amdgcn_readfirstlane(tid >> 6), c = lane & 31, hh = lane >> 5;
  bf16x8 af[4];
  {
    const int m = c, r = (m & 3) + 4 * (m >> 3), ql = 2 * ((m >> 2) & 1) + (r >> 3), head = r & 7;
    const bf16_t* qp = H1 + (tb + t0 + ql) * LD_H1 + 1536 + head * 64 + hh * 32;
#pragma unroll
    for (int j = 0; j < 4; ++j) af[j] = *(const bf16x8*)(qp + j * 8);
  }
  float wq0[8], wq1[8];
  {
    const f32x4 a0 = *(const f32x4*)(WI + (tb + t0 + 2 * hh) * 8), a1 = *(const f32x4*)(WI + (tb + t0 + 2 * hh) * 8 + 4);
    const f32x4 b0 = *(const f32x4*)(WI + (tb + t0 + 2 * hh + 1) * 8), b1 = *(const f32x4*)(WI + (tb + t0 + 2 * hh + 1) * 8 + 4);
#pragma unroll
    for (int j = 0; j < 4; ++j) { wq0[j] = a0[j] * 0.125f; wq0[4 + j] = a1[j] * 0.125f; wq1[j] = b0[j] * 0.125f; wq1[4 + j] = b1[j] * 0.125f; }
  }
  const int tq0 = t0 + 2 * hh, tq1 = tq0 + 1;
  unsigned k0[NI], k1[NI];
  {
    const bf16_t* kp = H1 + (tb + w * 32 + (lane >> 3)) * LD_H1 + 2048 + (lane & 7) * 8;
    char* tbuf = lds + 65536 + w * 4608;
    const int wofs = (lane >> 3) * 144 + (lane & 7) * 16, rofs = c * 144 + hh * 64;
    const int dq0 = w * 32 + c - tq0;
    bf16x8 ring[4][4], fr[2][4];
#pragma unroll
    for (int i = 0; i < 3; ++i) {
#pragma unroll
      for (int j = 0; j < 4; ++j) ring[i][j] = *(const bf16x8*)(kp + (size_t)j * 8 * LD_H1);
      kp += (size_t)256 * LD_H1;
    }
#pragma unroll
    for (int j = 0; j < 4; ++j) *(bf16x8*)(tbuf + wofs + j * 8 * 144) = ring[0][j];
#pragma unroll
    for (int j = 0; j < 4; ++j) fr[0][j] = *(const bf16x8*)(tbuf + rofs + j * 16);
    __builtin_amdgcn_sched_barrier(0);
#pragma unroll
    for (int i = 0; i < NI; ++i) {
      if (i + 3 < NI) {
#pragma unroll
        for (int j = 0; j < 4; ++j) ring[(i + 3) % 4][j] = *(const bf16x8*)(kp + (size_t)j * 8 * LD_H1);
        kp += (size_t)256 * LD_H1;
      }
      if (i + 1 < NI) {
#pragma unroll
        for (int j = 0; j < 4; ++j) *(bf16x8*)(tbuf + wofs + j * 8 * 144) = ring[(i + 1) % 4][j];
#pragma unroll
        for (int j = 0; j < 4; ++j) fr[(i + 1) & 1][j] = *(const bf16x8*)(tbuf + rofs + j * 16);
      }
      __builtin_amdgcn_sched_barrier(0);
      f32x16 acc;
#pragma unroll
      for (int r = 0; r < 16; ++r) acc[r] = 0.f;
#pragma unroll
      for (int j = 0; j < 4; ++j) acc = MFMA32(af[j], fr[i & 1][j], acc);
      float s0 = 0.f, s1 = 0.f;
#pragma unroll
      for (int r = 0; r < 8; ++r) { s0 += wq0[r] * fmaxf(acc[r], 0.f); s1 += wq1[r] * fmaxf(acc[8 + r], 0.f); }
      k0[i] = (dq0 <= -256 * i) ? okey(s0) : 0u;
      k1[i] = (dq0 <= 1 - 256 * i) ? okey(s1) : 0u;
      asm volatile("" : "+v"(k0[i]), "+v"(k1[i]));
      __builtin_amdgcn_sched_barrier(0);
    }
  }
  constexpr int CAP = 1024;
  unsigned* part = (unsigned*)lds;
  unsigned* ctl = (unsigned*)(lds + 256);
  unsigned* samp = (unsigned*)(lds + 512);
  unsigned* ckey = (unsigned*)(lds + 512 + 16384);
  unsigned* cpos = (unsigned*)(lds + 512 + 32768);
  unsigned* img = (unsigned*)(lds + 512 + 49152);
  unsigned Tm[4], Pc[4]; bool done[4];
#pragma unroll
  for (int q = 0; q < 4; ++q) { Pc[q] = 0; done[q] = (t0 + q + 1 <= 256); Tm[q] = 0; }
  const bool use_sample = (NI >= 8) && (t0 + 4 > 1024);
  if (tid < 4) ctl[tid] = 0;
  img[tid] = 0u; img[tid + 512] = 0u;
  if (use_sample) {
#pragma unroll
    for (int j = 0; j < NI / 8; ++j) {
      samp[(2 * hh) * 1024 + (j * 8 + w) * 32 + c] = k0[8 * j];
      samp[(2 * hh + 1) * 1024 + (j * 8 + w) * 32 + c] = k1[8 * j];
    }
  }
  __syncthreads();
  if (use_sample) {
    if (w < 4) {
      constexpr int SR = (NI / 8) * 4 > 0 ? (NI / 8) * 4 : 1;
      unsigned sk[SR];
#pragma unroll
      for (int r = 0; r < SR; ++r) sk[r] = samp[w * 1024 + r * 64 + lane];
      unsigned nvs = 0;
#pragma unroll
      for (int r = 0; r < SR; ++r) nvs += (unsigned)__popcll(__ballot(sk[r] >= 1u));
      const float f = (float)nvs / (float)(t0 + w + 1);
      const unsigned R = (unsigned)(256.f * f + 4.f * sqrtf(256.f * f * (1.f - f))) + 2u;
      unsigned T = 0;
      if (R < nvs) {
        for (int bit = 31; bit >= 0; --bit) {
          const unsigned cand = T | (1u << bit);
          unsigned n = 0;
#pragma unroll
          for (int r = 0; r < SR; ++r) n += (unsigned)__popcll(__ballot(sk[r] >= cand));
          if (n >= R) T = cand;
          if (n == R) break;
        }
      }
      if (lane == 0) ctl[4 + w] = T < 1u ? 1u : T;
    }
    __syncthreads();
  }
  {
    const unsigned loa = use_sample ? ctl[4 + 2 * hh] : 1u, lob = use_sample ? ctl[4 + 2 * hh + 1] : 1u;
    const int pbase = w * 32 + c;
    unsigned na = 0, nb = 0;
#pragma unroll
    for (int i = 0; i < NI; ++i) { na += (k0[i] >= loa) ? 1u : 0u; nb += (k1[i] >= lob) ? 1u : 0u; }
    unsigned ia = na, ib = nb;
#pragma unroll
    for (int o = 1; o < 32; o <<= 1) {
      const unsigned ta = __shfl_up(ia, o, 32), tb2 = __shfl_up(ib, o, 32);
      if (c >= o) { ia += ta; ib += tb2; }
    }
    unsigned basea = 0, baseb = 0;
    if (c == 31) { basea = atomicAdd(&ctl[2 * hh], ia); baseb = atomicAdd(&ctl[2 * hh + 1], ib); }
    basea = __shfl(basea, 31, 32); baseb = __shfl(baseb, 31, 32);
    unsigned sa = basea + ia - na, sb = baseb + ib - nb;
#pragma unroll
    for (int i = 0; i < NI; ++i) {
      if (k0[i] >= loa) { if (sa < (unsigned)CAP) { ckey[(2 * hh) * CAP + sa] = k0[i]; cpos[(2 * hh) * CAP + sa] = (unsigned)(pbase + 256 * i); } ++sa; }
      if (k1[i] >= lob) { if (sb < (unsigned)CAP) { ckey[(2 * hh + 1) * CAP + sb] = k1[i]; cpos[(2 * hh + 1) * CAP + sb] = (unsigned)(pbase + 256 * i); } ++sb; }
    }
  }
  __syncthreads();
  bool fast_ok = true;
#pragma unroll
  for (int q = 0; q < 4; ++q) { const unsigned n = ctl[q]; if (!done[q] && (n < 256u || n > (unsigned)CAP)) fast_ok = false; }
  if (fast_ok) {
    if (w < 4) {
      const unsigned ncand = ctl[w];
      unsigned ck[CAP / 64], cp[CAP / 64];
#pragma unroll
      for (int r = 0; r < CAP / 64; ++r) { const unsigned idx = r * 64 + lane; const bool v = idx < ncand; ck[r] = v ? ckey[w * CAP + idx] : 0u; cp[r] = v ? cpos[w * CAP + idx] : 0u; }
      unsigned T = 0; bool hit = (t0 + w + 1 <= 256);
      if (!hit) {
        for (int bit = 31; bit >= 0; --bit) {
          const unsigned cand = T | (1u << bit);
          unsigned n = 0;
#pragma unroll
          for (int r = 0; r < CAP / 64; ++r) n += (unsigned)__popcll(__ballot(ck[r] >= cand));
          if (n >= 256u) T = cand;
          if (n == 256u) { hit = true; break; }
        }
      } else T = 1u;
      unsigned tm, pc = 0;
      if (hit) tm = T - 1u;
      else {
        tm = T;
        unsigned ngt = 0;
#pragma unroll
        for (int r = 0; r < CAP / 64; ++r) ngt += (unsigned)__popcll(__ballot(ck[r] > T));
        const unsigned rr = 256u - ngt;
        for (int bit = 13; bit >= 0; --bit) {
          const unsigned pcand = pc | (1u << bit);
          unsigned n = 0;
#pragma unroll
          for (int r = 0; r < CAP / 64; ++r) n += (unsigned)__popcll(__ballot(ck[r] == T && cp[r] < pcand));
          if (n <= rr) pc = pcand;
        }
      }
#pragma unroll
      for (int r = 0; r < CAP / 64; ++r) {
        const bool sel = (ck[r] > tm) || (ck[r] == tm && cp[r] < pc);
        if (sel) atomicOr(&img[w * 256 + (cp[r] >> 5)], 1u << (cp[r] & 31u));
      }
    }
    __syncthreads();
    for (int idx = tid; idx < 4 * NI * 8; idx += 512) {
      const int q = idx / (NI * 8), kt = idx % (NI * 8);
      mask[(tb + t0 + q) * 256 + kt] = img[q * 256 + kt];
    }
    __syncthreads();
    return;
  } else {
    unsigned T[4];
#pragma unroll
    for (int q = 0; q < 4; ++q) T[q] = 0;
  int it = 0;
    for (int bit = 31; bit >= 0; --bit) {
      if (done[0] && done[1] && done[2] && done[3]) break;
      unsigned cand[4];
  #pragma unroll
      for (int q = 0; q < 4; ++q) cand[q] = T[q] | (1u << bit);
      unsigned tot[4];
      idx_count<NI>(k0, k1, hh ? cand[2] : cand[0], hh ? cand[3] : cand[1], 0, 0, 0, w, c, hh, part + (it & 1) * 32, tot);
      ++it;
  #pragma unroll
      for (int q = 0; q < 4; ++q)
        if (!done[q]) {
          if (tot[q] >= 256u) T[q] = cand[q];
          if (tot[q] == 256u) { done[q] = true; Tm[q] = cand[q] - 1u; }
        }
    }
    if (!(done[0] && done[1] && done[2] && done[3])) {
      unsigned tot[4], cand[4], rr[4];
  #pragma unroll
      for (int q = 0; q < 4; ++q) cand[q] = T[q] + 1u;
      idx_count<NI>(k0, k1, hh ? cand[2] : cand[0], hh ? cand[3] : cand[1], 0, 0, 0, w, c, hh, part + (it & 1) * 32, tot);
      ++it;
  #pragma unroll
      for (int q = 0; q < 4; ++q) { rr[q] = 256u - tot[q]; if (!done[q]) Tm[q] = T[q]; }
      unsigned P[4] = {0, 0, 0, 0};
      for (int bit = 13; bit >= 0; --bit) {
        unsigned pc[4];
  #pragma unroll
        for (int q = 0; q < 4; ++q) pc[q] = P[q] | (1u << bit);
        idx_count<NI>(k0, k1, hh ? T[2] : T[0], hh ? T[3] : T[1], 1, hh ? pc[2] : pc[0], hh ? pc[3] : pc[1], w, c, hh, part + (it & 1) * 32, tot);
        ++it;
  #pragma unroll
        for (int q = 0; q < 4; ++q) if (tot[q] <= rr[q]) P[q] = pc[q];
      }
  #pragma unroll
      for (int q = 0; q < 4; ++q) if (!done[q]) Pc[q] = P[q];
    }
}
  const unsigned tma = hh ? Tm[2] : Tm[0], tmb = hh ? Tm[3] : Tm[1], pca = hh ? Pc[2] : Pc[0], pcb = hh ? Pc[3] : Pc[1];
  const int dpa = w * 32 + c - (int)pca, dpb = w * 32 + c - (int)pcb;
#pragma unroll
  for (int i = 0; i < NI; ++i) {
    const int kt = w + 8 * i;
    const bool sa = (k0[i] > tma) || (k0[i] == tma && dpa < -256 * i);
    const bool sb = (k1[i] > tmb) || (k1[i] == tmb && dpb < -256 * i);
    const u64 ba = __ballot(sa), bb = __ballot(sb);
    if (c == 0) {
      mask[(tb + tq0) * 256 + kt] = hh ? (unsigned)(ba >> 32) : (unsigned)ba;
      mask[(tb + tq1) * 256 + kt] = hh ? (unsigned)(bb >> 32) : (unsigned)bb;
    }
  }
  __syncthreads();
}

DI void idx_item(const Params& p, int item, char* lds) {
  const int b = item & 3, t0 = (item >> 2) * 4;
  const int ni = (t0 + 4 + 255) >> 8;
  if (ni <= 4) idx_item_t<4>(p, b, t0, lds);
  else if (ni <= 8) idx_item_t<8>(p, b, t0, lds);
  else if (ni <= 12) idx_item_t<12>(p, b, t0, lds);
  else if (ni <= 16) idx_item_t<16>(p, b, t0, lds);
  else if (ni <= 20) idx_item_t<20>(p, b, t0, lds);
  else if (ni <= 24) idx_item_t<24>(p, b, t0, lds);
  else if (ni <= 28) idx_item_t<28>(p, b, t0, lds);
  else idx_item_t<32>(p, b, t0, lds);
}

DI void s5_scan(const Params& p) {
  const float* apow = (const float*)(p.ws + OFF_APOW); const float* xend = (const float*)(p.ws + OFF_XEND);
  bf16_t* Ug = (bf16_t*)((char*)p.out + OUT_UG);
  for (int gid = blockIdx.x * 512 + threadIdx.x; gid < 4 * 32 * 64 * 16; gid += gridDim.x * 512) {
    const int seg = gid & 15, pp = (gid >> 4) & 63, g = (gid >> 10) & 31, b = gid >> 15;
    const float ar = apow[2 * ((g * 33 + 32) * 64 + pp)], ai = apow[2 * ((g * 33 + 32) * 64 + pp) + 1];
    const size_t row0 = (size_t)(g * 1024 + b * 256 + seg * 16);
    float er[16], ei[16];
#pragma unroll
    for (int j = 0; j < 16; ++j) { const float2 e = *(const float2*)(xend + (row0 + j) * 128 + 2 * pp); er[j] = e.x; ei[j] = e.y; }
    float lr[16], li[16], xr = 0.f, xi = 0.f;
#pragma unroll
    for (int j = 0; j < 16; ++j) { lr[j] = xr; li[j] = xi; const float nr = ar * xr - ai * xi + er[j], ni = ar * xi + ai * xr + ei[j]; xr = nr; xi = ni; }
    float pr = ar, pi = ai;
#pragma unroll
    for (int k = 0; k < 4; ++k) { const float nr = pr * pr - pi * pi, ni = 2.f * pr * pi; pr = nr; pi = ni; }
    float cr = 0.f, ci = 0.f;
#pragma unroll
    for (int sidx = 0; sidx < 15; ++sidx) {
      const float sr = __shfl(xr, sidx, 16), si = __shfl(xi, sidx, 16);
      if (seg > sidx) { const float nr = pr * cr - pi * ci + sr, ni = pr * ci + pi * cr + si; cr = nr; ci = ni; }
    }
#pragma unroll
    for (int j = 0; j < 16; ++j) {
      *(unsigned*)(Ug + (row0 + j) * 640 + 512 + 2 * pp) = pack2(lr[j] + cr, li[j] + ci);
      const float nr = ar * cr - ai * ci, ni = ar * ci + ai * cr; cr = nr; ci = ni;
    }
  }
}

DI void mlp_and_ln(const Params& p, int layer, int ph, char* lds) {
}

template <int ph> DI void run_phase(const Params& p, char* lds) {
  char* ws = p.ws; char* ob = (char*)p.out;
  const int nb = gridDim.x, bid = blockIdx.x;
  switch (ph) {
    case 0: phase_prep(p, lds); break;
    case 1: {
      big_gemm8(lds, (const bf16_t*)(ws + OFF_XB), (const bf16_t*)(ws + OFF_WT_IN0), 2048, 1024, El8Bf16{(bf16_t*)(ws + OFF_H0), LD_H0});
      s5_ktab(p);
    } break;
    case 2: {
      const bf16_t* H0 = (const bf16_t*)(ws + OFF_H0);
      float* rs = (float*)(lds + LDS_AUX);
      for (int t = bid; t < 128 * 14; t += nb) {
        const int mt = t / 14, nt = t % 14, m0 = mt * 256;
        const bool isq = nt < 6;
        const int coff = isq ? 1552 : 1808, kk = isq ? 256 : 128;
        {
          const int row = threadIdx.x >> 1, half = threadIdx.x & 1, cnt = kk / 2;
          const bf16_t* src = H0 + (size_t)(m0 + row) * LD_H0 + coff + half * cnt;
          float s = 0.f;
          for (int i = 0; i < cnt; i += 8) {
            const uint4 v = *(const uint4*)(src + i);
            float a;
            a = lo_bf(v.x); s += a * a; a = hi_bf(v.x); s += a * a; a = lo_bf(v.y); s += a * a; a = hi_bf(v.y); s += a * a;
            a = lo_bf(v.z); s += a * a; a = hi_bf(v.z); s += a * a; a = lo_bf(v.w); s += a * a; a = hi_bf(v.w); s += a * a;
          }
          s += __shfl_xor(s, 1);
          if (half == 0) rs[row] = rsqrtf(s / (float)kk + LN_EPS);
          __syncthreads();
        }
        if (isq) {
          EpiUQ epi{(bf16_t*)(ws + OFF_Q0), (const int*)p.in[1], rs, m0};
          gemm_tile(H0 + 1552, LD_H0, (const bf16_t*)(ws + OFF_WT_UQ), 256, 256, m0, nt * 128, lds, epi);
        } else {
          EpiUKV epi{(bf16_t*)(ws + OFF_K0), (bf16_t*)(ws + OFF_VT0), rs, m0};
          gemm_tile(H0 + 1808, LD_H0, (const bf16_t*)(ws + OFF_WT_UKV), 128, 128, m0, (nt - 6) * 128, lds, epi);
        }
        __syncthreads();
      }
      {
        bf16_t* Kb = (bf16_t*)(ws + OFF_K0); const int* pos = (const int*)p.in[1];
        for (int i = bid * 512 + threadIdx.x; i < NTOK * 16; i += nb * 512) {
          const int row = i >> 4, fi = i & 15;
          const float t1 = bf2f(H0[(size_t)row * LD_H0 + 1936 + fi]), t2 = bf2f(H0[(size_t)row * LD_H0 + 1952 + fi]);
          float cs, sn; rope_cs(pos[row], fi, cs, sn);
          const bf16_t o1 = f2bf(t1 * cs - t2 * sn), o2 = f2bf(t2 * cs + t1 * sn);
#pragma unroll
          for (int h = 0; h < 8; ++h) { Kb[(size_t)row * 768 + h * 96 + 64 + fi] = o1; Kb[(size_t)row * 768 + h * 96 + 80 + fi] = o2; }
        }
      }
      for (int it = bid; it < 2048; it += nb) gla_stageA(p, it, lds);
    } break;
    case 3: gla_scan(p); break;
    case 4: {
      const float sl2 = 0.10206207261596577f * 1.4426950408889634f;
      for (int u = bid; u < 1024; u += nb) {
        const int j = u & 255, rd = u >> 8, bh = j >> 3, sub = j & 7;
        const int qb = (rd == 0) ? sub : (rd == 1) ? 15 - sub : (rd == 2) ? 16 + sub : 31 - sub;
        attn_item<96, false>((const bf16_t*)(ws + OFF_Q0), 768, (const bf16_t*)(ws + OFF_K0), 768, (const bf16_t*)(ws + OFF_VT0),
                             (bf16_t*)(ob + OUT_OMIX0), 512, nullptr, bh >> 3, bh & 7, qb, sl2, lds);
      }
      for (int it = bid; it < 2048; it += nb) gla_stageC(p, it, lds);
    } break;
    case 5: case 15: {
      const bool l1 = ph == 15;
      const bf16_t* A = (const bf16_t*)(ob + (l1 ? OUT_OMIX1 : OUT_OMIX0));
      const bf16_t* Bt = (const bf16_t*)(ws + (l1 ? OFF_WT_OUT1 : OFF_WT_OUT0));
      if (l1) big_gemm8(lds, A, Bt, 1024, 1024, El8ResidB{(const bf16_t*)(ws + OFF_XB), (float*)(ws + OFF_XF)});
      else big_gemm8(lds, A, Bt, 1024, 1024, El8ResidF{p.in[0], (float*)(ws + OFF_XF)});
    } break;
    case 6: phase_ln((const float*)(ws + OFF_XF), nullptr, (bf16_t*)(ws + OFF_XB), p.in[11], p.in[12]); break;
    case 16: phase_ln((const float*)(ws + OFF_XF), nullptr, (bf16_t*)(ws + OFF_XB), p.in[29], p.in[30]); break;
    case 7: case 17: {
      const bf16_t* Bt = (const bf16_t*)(ws + (ph == 17 ? OFF_WT_11 : OFF_WT_10));
      big_gemm8(lds, (const bf16_t*)(ws + OFF_XB), Bt, 4096, 1024, El8Relu2{(bf16_t*)(ws + OFF_HMID), 4096});
    } break;
    case 8: case 18: {
      const bf16_t* Bt = (const bf16_t*)(ws + (ph == 18 ? OFF_WT_21 : OFF_WT_20));
      big_gemm8(lds, (const bf16_t*)(ws + OFF_HMID), Bt, 1024, 4096, El8ResidB{(const bf16_t*)(ws + OFF_XB), (float*)(ws + OFF_XF)});
    } break;
    case 9: phase_ln((const float*)(ws + OFF_XF), nullptr, (bf16_t*)(ws + OFF_XB), p.in[15], p.in[16]); break;
    case 19: phase_ln((const float*)(ws + OFF_XF), p.out, nullptr, p.in[33], p.in[34]); break;
    case 10: {
      ElH1 el{(bf16_t*)(ws + OFF_H1), (bf16_t*)(ws + OFF_VT1), (float*)(ws + OFF_WI), (bf16_t*)(ob + OUT_UG)};
      {
        pg8::Gemm g{(const bf16_t*)(ws + OFF_XB), (const bf16_t*)(ws + OFF_WT_IN1), NTOK, 2048, 1024}; pg8::StaticOrder S; S.init(NTOK, 2048, (int)gridDim.x, (int)blockIdx.x);
        P8H1 E{(bf16_t*)(ws + OFF_H1), (bf16_t*)(ws + OFF_VT1)};
        pg8::gemm_phase<P8H1, pg8::StaticOrder, true, true>((PG8_LAS unsigned char*)lds, g, S, E);
        __syncthreads();
      }
      EpiEl<ElH1> epi{el};
      for (int t = bid; t < 128 * 5; t += nb) gemm_tile((const bf16_t*)(ws + OFF_XB), 1024, (const bf16_t*)(ws + OFF_WT_IN1), 1024, 1024, (t / 5) * 256, 2048 + (t % 5) * 128, lds, epi);
      s5_expand(p);
    } break;
    case 11: {
      for (int t = bid; t < 32 * 4; t += nb) {
        const int g = t >> 2, mt = t & 3;
        EpiF32 epi{(float*)(ws + OFF_XEND) + (size_t)g * 1024 * 128, 128};
        gemm_tile((const bf16_t*)(ob + OUT_UG) + (size_t)g * 1024 * 640, 640, (const bf16_t*)(ob + OUT_E) + (size_t)g * 128 * 512, 512, 512, mt * 256, 0, lds, epi);
      }
      for (int it = bid; it < 8192; it += nb) idx_item(p, it, lds);
    } break;
    case 12: {
      s5_scan(p);
      const float sl2 = 0.125f * 1.4426950408889634f;
      for (int u = bid; u < 1024; u += nb) {
        const int j = u & 255, rd = u >> 8, bh = j >> 3, sub = j & 7;
        const int qb = (rd == 0) ? sub : (rd == 1) ? 15 - sub : (rd == 2) ? 16 + sub : 31 - sub;
        attn_item<64, true>((const bf16_t*)(ws + OFF_H1), LD_H1, (const bf16_t*)(ws + OFF_H1) + 512, LD_H1, (const bf16_t*)(ws + OFF_VT1),
                            (bf16_t*)(ob + OUT_OMIX1), 0, (const unsigned*)(ws + OFF_MASK), bh >> 3, bh & 7, qb, sl2, lds);
      }
    } break;
    case 13: {
      for (int t = bid; t < 32 * 16; t += nb) {
        const int g = t >> 4, mt = (t >> 2) & 3, nt = t & 3;
        EpiS5Y epi{(const bf16_t*)(ob + OUT_UG), p.in[24], (bf16_t*)(ws + OFF_YACT), g};
        gemm_tile((const bf16_t*)(ob + OUT_UG) + (size_t)g * 1024 * 640, 640, (const bf16_t*)(ob + OUT_TF) + (size_t)g * 512 * 640, 640, 640, mt * 256, nt * 128, lds, epi);
      }
    } break;
    case 14: {
      EpiGLU epi{(const bf16_t*)(ws + OFF_YACT), p.in[27], (bf16_t*)(ob + OUT_OMIX1)};
      for (int t = bid; t < 128 * 4; t += nb) gemm_tile((const bf16_t*)(ws + OFF_YACT), 512, (const bf16_t*)(ws + OFF_WT_GLU), 512, 512, (t >> 2) * 256, (t & 3) * 128, lds, epi);
    } break;
    default: break;
  }
}


#define LAS __attribute__((address_space(3)))
#define XB_TMO      128
#define XB_XCNT(j)  (256  + 64 * (j))
#define XB_XSUB(j)  (1280 + 64 * (j))
#define XB_XGEN(j)  (2304 + 64 * (j))
#define XB_TOP      3328
#define XB_TOPGEN   3392
#define XCD_BAR_WORDS 3456
#define XB_SPIN_CAP (1u << 18)

__device__ __forceinline__ unsigned xb_ld(unsigned* p)              { return __hip_atomic_load(p, __ATOMIC_RELAXED, __HIP_MEMORY_SCOPE_AGENT); }
__device__ __forceinline__ unsigned xb_add(unsigned* p, unsigned v) { return __hip_atomic_fetch_add(p, v, __ATOMIC_RELAXED, __HIP_MEMORY_SCOPE_AGENT); }
__device__ __forceinline__ unsigned xb_xcc_id() { return (unsigned)__builtin_amdgcn_s_getreg((3 << 11) | 20) & 0xFu; }
#define XB_SPIN(cond, bar) do { unsigned _sp = 0; while (cond) { __builtin_amdgcn_s_sleep(1); \
    if ((++_sp & 255u) == 0u) { if (xb_ld(&(bar)[XB_TMO])) break; if (_sp > XB_SPIN_CAP) { atomicAdd(&(bar)[XB_TMO], 1u); break; } } } } while (0)

struct XcdBarrier {
    unsigned* bar; unsigned x;
    volatile LAS unsigned* st;
};

__device__ __forceinline__ XcdBarrier xcd_barrier_post(unsigned* bar, volatile LAS unsigned* st) {
    XcdBarrier b; b.bar = bar; b.x = xb_xcc_id(); b.st = st;
    if (threadIdx.x == 0) (void)xb_add(&bar[XB_XCNT(b.x)], 1u);
    return b;
}
__device__ __forceinline__ void xcd_barrier_complete(unsigned* bar, unsigned x, unsigned& nloc, unsigned& nx) {
    const unsigned G = gridDim.x * gridDim.y * gridDim.z;
    unsigned sum, cnt, mine, sp = 0u;
    for (;;) {
        sum = 0u; cnt = 0u; mine = 0u;
#pragma unroll
        for (unsigned j = 0; j < 16; ++j) { const unsigned c = xb_ld(&bar[XB_XCNT(j)]); sum += c; cnt += (c > 0u) ? 1u : 0u; mine = (j == x) ? c : mine; }
        if (sum == G) break;
        __builtin_amdgcn_s_sleep(1);
        if ((++sp & 255u) == 0u) { if (xb_ld(&bar[XB_TMO])) break; if (sp > XB_SPIN_CAP) { atomicAdd(&bar[XB_TMO], 1u); break; } }
    }
    nloc = mine > 0u ? mine : 1u; nx = cnt > 0u ? cnt : 1u;
}

__device__ __forceinline__ void xcd_barrier(const XcdBarrier& b) {
    asm volatile("s_waitcnt vmcnt(0)" ::: "memory");
    __syncthreads();
    if (threadIdx.x == 0) {
        unsigned* bar = b.bar;
        __builtin_amdgcn_s_waitcnt(0);
        unsigned nloc = b.st[0], nx = b.st[1];
        if (nloc == 0u) { xcd_barrier_complete(bar, b.x, nloc, nx); b.st[0] = nloc; b.st[1] = nx; }
        const unsigned old = xb_add(&bar[XB_XSUB(b.x)], 1u);
        const unsigned gen = old / nloc;
        if (old + 1u == (gen + 1u) * nloc) {
            __builtin_amdgcn_fence(__ATOMIC_RELEASE, "agent");
            asm volatile("s_waitcnt vmcnt(0)" ::: "memory");
            const unsigned og = xb_add(&bar[XB_TOP], 1u);
            const unsigned tg = og / nx;
            if (og + 1u == (tg + 1u) * nx) xb_add(&bar[XB_TOPGEN], 1u);
            else XB_SPIN(xb_ld(&bar[XB_TOPGEN]) == tg, bar);
            __builtin_amdgcn_fence(__ATOMIC_ACQUIRE, "agent");
            xb_add(&bar[XB_XGEN(b.x)], 1u);
            asm volatile("s_waitcnt vmcnt(0)" ::: "memory");
        } else {
            XB_SPIN(xb_ld(&bar[XB_XGEN(b.x)]) == gen, bar);
            __builtin_amdgcn_fence(__ATOMIC_ACQUIRE, "agent");
            asm volatile("s_waitcnt vmcnt(0)" ::: "memory");
        }
    }
    __syncthreads();
}

__global__ void __launch_bounds__(512) mega(Params p) {
  extern __shared__ __attribute__((aligned(16))) char smem[];
  cg::grid_group grid = cg::this_grid();
  volatile LAS unsigned* bst = (volatile LAS unsigned*)(LAS char*)(smem + LDS_TOTAL - 16);
  if (threadIdx.x == 0) { bst[0] = 0u; bst[1] = 0u; }
  __syncthreads();
  const XcdBarrier xbar = xcd_barrier_post((unsigned*)(p.ws + OFF_MISC + 7 * MiB), bst);
  if (p.ph_lo > 1000) grid.sync();
#define GBAR() xcd_barrier(xbar)
#define STEP(PH) if (PH >= p.ph_lo && PH <= p.ph_hi) { run_phase<PH>(p, smem); if ((p.dup >> PH) & 1u) { GBAR(); run_phase<PH>(p, smem); } if (PH < p.ph_hi) GBAR(); }
  STEP(0) STEP(1) STEP(2) STEP(3) STEP(4) STEP(5) STEP(6) STEP(7) STEP(8) STEP(9)
  STEP(10) STEP(11) STEP(12) STEP(13) STEP(14) STEP(15) STEP(16) STEP(17) STEP(18) STEP(19)
}

#ifndef DUP_MASK
#define DUP_MASK 0u
#endif
#ifndef MULTI_LAUNCH
#define MULTI_LAUNCH 0
#endif

extern "C" void kernel_launch(void* const* d_in, const int* in_sizes, int n_in, void* d_out, int out_size,
                              void* d_ws, size_t ws_size, hipStream_t stream) {
  constexpr size_t kDynLds = LDS_TOTAL;
  static int grid_blocks = 0;
  if (!grid_blocks) {
    (void)hipFuncSetAttribute((const void*)mega, hipFuncAttributeMaxDynamicSharedMemorySize, (int)kDynLds);
    int dev = 0, cus = 0, per_cu = 0;
    (void)hipGetDevice(&dev);
    (void)hipDeviceGetAttribute(&cus, hipDeviceAttributeMultiprocessorCount, dev);
    (void)hipOccupancyMaxActiveBlocksPerMultiprocessor(&per_cu, mega, 512, kDynLds);
    if (per_cu < 1) per_cu = 1;
    if (per_cu > 1) per_cu = 1;
    grid_blocks = cus * per_cu;
  }
  Params p{};
  for (int i = 0; i < 35; ++i) p.in[i] = (const float*)d_in[i];
  p.out = (float*)d_out; p.ws = (char*)d_ws; p.dup = DUP_MASK;
#if MULTI_LAUNCH
  for (int ph = 0; ph < 20; ++ph) {
    p.ph_lo = ph; p.ph_hi = ph;
    hipLaunchKernelGGL(mega, dim3(grid_blocks), dim3(512), kDynLds, stream, p);
  }
#else
  p.ph_lo = 0; p.ph_hi = 19;
  (void)hipMemsetAsync((char*)d_ws + OFF_MISC + 7 * MiB, 0, 16384, stream);
  void* args[] = {&p};
  hipError_t e = hipLaunchCooperativeKernel((void*)mega, dim3(grid_blocks), dim3(512), args, kDynLds, stream);
  if (e != hipSuccess) fprintf(stderr, "cooperative launch failed: %s (grid %d)\n", hipGetErrorString(e), grid_blocks);
#endif
}
#ifdef PHASE_TEST
template <int PH> __global__ void __launch_bounds__(512) tk(Params p) { extern __shared__ __attribute__((aligned(16))) char smem2[]; run_phase<PH>(p, smem2); }
template __global__ void tk<0>(Params); template __global__ void tk<1>(Params); template __global__ void tk<2>(Params); template __global__ void tk<3>(Params);
template __global__ void tk<4>(Params); template __global__ void tk<5>(Params); template __global__ void tk<6>(Params); template __global__ void tk<7>(Params);
template __global__ void tk<8>(Params); template __global__ void tk<10>(Params); template __global__ void tk<11>(Params); template __global__ void tk<12>(Params);
template __global__ void tk<13>(Params); template __global__ void tk<14>(Params); template __global__ void tk<19>(Params);
#endif
```

```cpp
#include <hip/hip_runtime.h>
#include <hip/hip_cooperative_groups.h>
#include <cstdio>
#include <cstdint>
namespace cg = cooperative_groups;

#define DI __device__ __forceinline__
typedef unsigned short bf16_t;
typedef short bf16x8 __attribute__((ext_vector_type(8)));
typedef short s16x4 __attribute__((ext_vector_type(4)));
typedef float f32x4 __attribute__((ext_vector_type(4)));
typedef float f32x16 __attribute__((ext_vector_type(16)));
typedef unsigned long long u64;

constexpr int NTOK = 32768, SEQ = 8192, DM = 1024;
constexpr size_t MiB = (size_t)1 << 20;
constexpr size_t OFF_WT_IN0 = 0, OFF_WT_OUT0 = 4 * MiB, OFF_WT_10 = 6 * MiB, OFF_WT_20 = 14 * MiB, OFF_WT_IN1 = 22 * MiB,
                 OFF_WT_OUT1 = 28 * MiB, OFF_WT_11 = 30 * MiB, OFF_WT_21 = 38 * MiB, OFF_WT_UQ = 46 * MiB,
                 OFF_WT_UKV = 46 * MiB + 512 * 1024, OFF_WT_GLU = 47 * MiB;
constexpr size_t OFF_XB = 56 * MiB, OFF_XF = 120 * MiB, OFF_BIG = 248 * MiB, OFF_MISC = 504 * MiB;
constexpr size_t OFF_H0 = OFF_BIG, OFF_Q0 = OFF_XF, OFF_K0 = OFF_XF + 48 * MiB, OFF_VT0 = OFF_XF + 96 * MiB;
constexpr size_t OFF_DECAY = OFF_MISC, OFF_APOW = OFF_MISC + 1 * MiB, OFF_BBAR = OFF_MISC + 2 * MiB, OFF_KTAB = OFF_MISC + 3 * MiB,
                 OFF_WI = OFF_MISC + 4 * MiB;
constexpr size_t OFF_H1 = OFF_BIG, OFF_MASK = OFF_BIG + 168 * MiB, OFF_VT1 = OFF_BIG + 200 * MiB, OFF_XEND = OFF_BIG + 232 * MiB;
constexpr size_t OFF_YACT = OFF_XF, OFF_HMID = OFF_BIG;
constexpr size_t OUT_CKV = 0, OUT_OMIX0 = 64 * MiB, OUT_OMIX1 = 0, OUT_UG = 64 * MiB, OUT_TF = 104 * MiB, OUT_E = 124 * MiB;

constexpr int LD_H0 = 2048, LD_H1 = 2688;
constexpr float ALPHA = 1.4142135623730951f;
constexpr float LN_EPS = 1e-5f;

__constant__ float INV_FREQ[16] = {1.0f, 0.5623413324356079f, 0.3162277638912201f, 0.17782793939113617f, 0.10000000149011612f,
  0.05623413249850273f, 0.03162277489900589f, 0.017782794311642647f, 0.009999999776482582f, 0.005623413249850273f,
  0.003162277629598975f, 0.0017782794311642647f, 0.0010000000474974513f, 0.000562341301701963f, 0.0003162277571391314f,
  0.00017782794020604342f};

struct Params {
  const float* in[35];
  float* out;
  char* ws;
  int ph_lo, ph_hi;
  unsigned dup; int pad_;
};

DI bf16_t f2bf(float x) { unsigned u = __float_as_uint(x); u += 0x7fffu + ((u >> 16) & 1u); return (bf16_t)(u >> 16); }
DI float bf2f(bf16_t b) { return __uint_as_float(((unsigned)b) << 16); }
DI unsigned pack2(float a, float b) { unsigned r; asm("v_cvt_pk_bf16_f32 %0, %1, %2" : "=v"(r) : "v"(a), "v"(b)); return r; }
DI uint2 pack4(f32x4 v) { uint2 r; r.x = pack2(v[0], v[1]); r.y = pack2(v[2], v[3]); return r; }
DI float lo_bf(unsigned u) { return __uint_as_float(u << 16); }
DI float hi_bf(unsigned u) { return __uint_as_float(u & 0xffff0000u); }
#define MFMA16(a, b, c) __builtin_amdgcn_mfma_f32_16x16x32_bf16((a), (b), (c), 0, 0, 0)
#define MFMA32(a, b, c) __builtin_amdgcn_mfma_f32_32x32x16_bf16((a), (b), (c), 0, 0, 0)
DI int crow(int reg, int h) { return (reg & 3) + 8 * (reg >> 2) + 4 * h; }

constexpr int G_RS = 144;
constexpr int G_ABUF = 256 * G_RS, G_BBUF = 128 * G_RS;
constexpr int G_LDS = 2 * G_ABUF + 2 * G_BBUF;
constexpr int LDS_AUX = G_LDS;
constexpr int LDS_TOTAL = 131072 + 4096;

typedef unsigned u32x4 __attribute__((ext_vector_type(4)));
struct Stage { u32x4 a0, a1, a2, a3, b0, b1; };

DI void g_load(Stage& s, const bf16_t* A, int lda, const bf16_t* Bt, int ldb, int m0, int n0, int kt, int tid) {
  const int r = tid >> 3, c = tid & 7;
  const bf16_t* ap = A + (size_t)(m0 + r) * lda + kt * 64 + c * 8;
  s.a0 = *(const u32x4*)(ap); s.a1 = *(const u32x4*)(ap + (size_t)64 * lda); s.a2 = *(const u32x4*)(ap + (size_t)128 * lda); s.a3 = *(const u32x4*)(ap + (size_t)192 * lda);
  const bf16_t* bp = Bt + (size_t)(n0 + r) * ldb + kt * 64 + c * 8;
  s.b0 = *(const u32x4*)(bp); s.b1 = *(const u32x4*)(bp + (size_t)64 * ldb);
}
DI void g_write(const Stage& s, char* sA, char* sB, int tid) {
  const int r = tid >> 3, c = tid & 7;
  char* ap = sA + r * G_RS + c * 16;
  *(u32x4*)(ap) = s.a0; *(u32x4*)(ap + 64 * G_RS) = s.a1; *(u32x4*)(ap + 128 * G_RS) = s.a2; *(u32x4*)(ap + 192 * G_RS) = s.a3;
  char* bp = sB + r * G_RS + c * 16;
  *(u32x4*)(bp) = s.b0; *(u32x4*)(bp + 64 * G_RS) = s.b1;
}
DI void g_compute(f32x4 (&acc)[4][4], const char* sA, const char* sB, int wr, int wc, int fr, int fq) {
#pragma unroll
  for (int ks = 0; ks < 2; ++ks) {
    bf16x8 am[4], bn[4];
#pragma unroll
    for (int mi = 0; mi < 4; ++mi) am[mi] = *(const bf16x8*)(sA + (wr * 64 + mi * 16 + fr) * G_RS + ks * 64 + fq * 16);
#pragma unroll
    for (int ni = 0; ni < 4; ++ni) bn[ni] = *(const bf16x8*)(sB + (wc * 64 + ni * 16 + fr) * G_RS + ks * 64 + fq * 16);
#pragma unroll
    for (int mi = 0; mi < 4; ++mi)
#pragma unroll
      for (int ni = 0; ni < 4; ++ni) acc[mi][ni] = MFMA16(bn[ni], am[mi], acc[mi][ni]);
  }
}

template <class Epi>
DI void gemm_tile(const bf16_t* __restrict__ A, int lda, const bf16_t* __restrict__ Bt, int ldb, int K, int m0, int n0, char* lds, const Epi& epi) {
  const int tid = threadIdx.x, lane = tid & 63, wid = tid >> 6, wr = wid >> 1, wc = wid & 1, fr = lane & 15, fq = lane >> 4;
  char* sA0 = lds; char* sA1 = lds + G_ABUF; char* sB0 = lds + 2 * G_ABUF; char* sB1 = sB0 + G_BBUF;
  f32x4 acc[4][4];
#pragma unroll
  for (int mi = 0; mi < 4; ++mi)
#pragma unroll
    for (int ni = 0; ni < 4; ++ni) acc[mi][ni] = (f32x4){0.f, 0.f, 0.f, 0.f};
  const int nk = K >> 6;
  Stage R0, R1;
  g_load(R0, A, lda, Bt, ldb, m0, n0, 0, tid);
  g_load(R1, A, lda, Bt, ldb, m0, n0, 1, tid);
  g_write(R0, sA0, sB0, tid);
  if (2 < nk) g_load(R0, A, lda, Bt, ldb, m0, n0, 2, tid);
  __syncthreads();
  for (int kt = 0; kt < nk; kt += 2) {
    g_compute(acc, sA0, sB0, wr, wc, fr, fq);
    g_write(R1, sA1, sB1, tid);
    if (kt + 3 < nk) g_load(R1, A, lda, Bt, ldb, m0, n0, kt + 3, tid);
    __syncthreads();
    g_compute(acc, sA1, sB1, wr, wc, fr, fq);
    if (kt + 2 < nk) g_write(R0, sA0, sB0, tid);
    if (kt + 4 < nk) g_load(R0, A, lda, Bt, ldb, m0, n0, kt + 4, tid);
    __syncthreads();
  }
  epi(acc, m0 + wr * 64, n0 + wc * 64, fr, fq);
}

struct EpiBf16 {
  bf16_t* O; int ld;
  DI void operator()(const f32x4 (&acc)[4][4], int mw, int nw, int fr, int fq) const {
#pragma unroll
    for (int mi = 0; mi < 4; ++mi)
#pragma unroll
      for (int ni = 0; ni < 4; ++ni) *(uint2*)(O + (size_t)(mw + mi * 16 + fr) * ld + nw + ni * 16 + fq * 4) = pack4(acc[mi][ni]);
  }
};
struct EpiRelu2 {
  bf16_t* O; int ld;
  DI void operator()(const f32x4 (&acc)[4][4], int mw, int nw, int fr, int fq) const {
#pragma unroll
    for (int mi = 0; mi < 4; ++mi)
#pragma unroll
      for (int ni = 0; ni < 4; ++ni) {
        f32x4 v = acc[mi][ni];
#pragma unroll
        for (int j = 0; j < 4; ++j) { float t = fmaxf(v[j], 0.f); v[j] = t * t; }
        *(uint2*)(O + (size_t)(mw + mi * 16 + fr) * ld + nw + ni * 16 + fq * 4) = pack4(v);
      }
  }
};
struct EpiResid {
  const float* X; float* Y;
  DI void operator()(const f32x4 (&acc)[4][4], int mw, int nw, int fr, int fq) const {
#pragma unroll
    for (int mi = 0; mi < 4; ++mi)
#pragma unroll
      for (int ni = 0; ni < 4; ++ni) {
        size_t o = (size_t)(mw + mi * 16 + fr) * DM + nw + ni * 16 + fq * 4;
        f32x4 x = *(const f32x4*)(X + o);
        *(f32x4*)(Y + o) = x * ALPHA + acc[mi][ni];
      }
  }
};
DI void rope_cs(int pos, int i, float& c, float& s) {
  float a = (float)pos * INV_FREQ[i];
  double rev = (double)a * 0.15915494309189535;
  rev -= rint(rev);
  float r = (float)(rev * 6.283185307179586);
  c = __cosf(r); s = __sinf(r);
}
struct EpiUQ {
  bf16_t* Q; const int* pos; const float* rs; int m0;
  DI void operator()(const f32x4 (&acc)[4][4], int mw, int nw, int fr, int fq) const {
    const int c0 = nw % 96;
    const int rope_ni = (c0 == 64) ? 0 : (c0 == 32 ? 2 : 4);
#pragma unroll
    for (int mi = 0; mi < 4; ++mi) {
      const int row = mw + mi * 16 + fr;
      const float sc = rs[row - m0];
      f32x4 v[4];
#pragma unroll
      for (int ni = 0; ni < 4; ++ni) v[ni] = acc[mi][ni] * sc;
      if (rope_ni < 4) {
        const int ps = pos[row];
#pragma unroll
        for (int j = 0; j < 4; ++j) {
          float c, s; rope_cs(ps, fq * 4 + j, c, s);
          if (rope_ni == 0) { float t1 = v[0][j], t2 = v[1][j]; v[0][j] = t1 * c - t2 * s; v[1][j] = t2 * c + t1 * s; }
          else { float t1 = v[2][j], t2 = v[3][j]; v[2][j] = t1 * c - t2 * s; v[3][j] = t2 * c + t1 * s; }
        }
      }
#pragma unroll
      for (int ni = 0; ni < 4; ++ni) *(uint2*)(Q + (size_t)row * 768 + nw + ni * 16 + fq * 4) = pack4(v[ni]);
    }
  }
};
struct EpiUKV {
  bf16_t* Kb; bf16_t* VT; const float* rs; int m0;
  DI void operator()(const f32x4 (&acc)[4][4], int mw, int nw, int fr, int fq) const {
    const int h = nw >> 7; const bool isv = (nw & 64) != 0;
#pragma unroll
    for (int mi = 0; mi < 4; ++mi) {
      const int row = mw + mi * 16 + fr;
      const float sc = rs[row - m0];
      const int b = row >> 13, l = row & 8191;
#pragma unroll
      for (int ni = 0; ni < 4; ++ni) {
        f32x4 v = acc[mi][ni] * sc;
        if (!isv) *(uint2*)(Kb + (size_t)row * 768 + h * 96 + ni * 16 + fq * 4) = pack4(v);
        else {
#pragma unroll
          for (int j = 0; j < 4; ++j) VT[((size_t)((b * 8 + h) * 64 + ni * 16 + fq * 4 + j)) * SEQ + l] = f2bf(v[j]);
        }
      }
    }
  }
};
struct EpiH1 {
  bf16_t* H1; bf16_t* VT; float* WI; bf16_t* Ug;
  DI void operator()(const f32x4 (&acc)[4][4], int mw, int nw, int fr, int fq) const {
#pragma unroll
    for (int mi = 0; mi < 4; ++mi) {
      const int row = mw + mi * 16 + fr;
      const int b = row >> 13, l = row & 8191;
#pragma unroll
      for (int ni = 0; ni < 4; ++ni) {
        const int col = nw + ni * 16 + fq * 4;
        const f32x4 v = acc[mi][ni];
        if (col < 1024 || (col >= 1536 && col < 2112)) *(uint2*)(H1 + (size_t)row * LD_H1 + col) = pack4(v);
        else if (col < 1536) {
          const int hc = col - 1024, h = hc >> 6, e = hc & 63;
#pragma unroll
          for (int j = 0; j < 4; ++j) VT[((size_t)((b * 8 + h) * 64 + e + j)) * SEQ + l] = f2bf(v[j]);
        } else if (col < 2120) {
          *(f32x4*)(WI + (size_t)row * 8 + (col - 2112)) = v * 0.35355339059327373f;
        } else if (col < 2632) {
          const int ch = col - 2120, g = ch >> 4, ci = ch & 15;
          *(uint2*)(Ug + ((size_t)(g * 1024 + (row >> 5))) * 640 + (row & 31) * 16 + ci) = pack4(v);
        }
      }
    }
  }
};
struct EpiF32 {
  float* O; int ld;
  DI void operator()(const f32x4 (&acc)[4][4], int mw, int nw, int fr, int fq) const {
#pragma unroll
    for (int mi = 0; mi < 4; ++mi)
#pragma unroll
      for (int ni = 0; ni < 4; ++ni) *(f32x4*)(O + (size_t)(mw + mi * 16 + fr) * ld + nw + ni * 16 + fq * 4) = acc[mi][ni];
  }
};
DI float gelu_tanh(float x) {
  float u = 0.7978845608028654f * (x + 0.044715f * x * x * x);
  float t = 1.f - 2.f / (__expf(2.f * u) + 1.f);
  return 0.5f * x * (1.f + t);
}
struct EpiS5Y {
  const bf16_t* Ug; const float* D; bf16_t* Y; int g;
  DI void operator()(const f32x4 (&acc)[4][4], int mw, int nw, int fr, int fq) const {
#pragma unroll
    for (int mi = 0; mi < 4; ++mi) {
      const int bc = mw + mi * 16 + fr;
#pragma unroll
      for (int ni = 0; ni < 4; ++ni) {
        const int col = nw + ni * 16 + fq * 4, i = col >> 4, co = col & 15;
        const uint2 uu = *(const uint2*)(Ug + ((size_t)(g * 1024 + bc)) * 640 + col);
        const f32x4 d = *(const f32x4*)(D + g * 16 + co);
        f32x4 v = acc[mi][ni];
        v[0] = gelu_tanh(v[0] + d[0] * lo_bf(uu.x)); v[1] = gelu_tanh(v[1] + d[1] * hi_bf(uu.x));
        v[2] = gelu_tanh(v[2] + d[2] * lo_bf(uu.y)); v[3] = gelu_tanh(v[3] + d[3] * hi_bf(uu.y));
        *(uint2*)(Y + ((size_t)(bc * 32 + i)) * 512 + g * 16 + co) = pack4(v);
      }
    }
  }
};
struct EpiGLU {
  const bf16_t* Y; const float* bias; bf16_t* O;
  DI void operator()(const f32x4 (&acc)[4][4], int mw, int nw, int fr, int fq) const {
#pragma unroll
    for (int mi = 0; mi < 4; ++mi) {
      const int row = mw + mi * 16 + fr;
#pragma unroll
      for (int ni = 0; ni < 4; ++ni) {
        const int col = nw + ni * 16 + fq * 4;
        const uint2 yy = *(const uint2*)(Y + (size_t)row * 512 + col);
        const f32x4 bb = *(const f32x4*)(bias + col);
        f32x4 v = acc[mi][ni] + bb;
        v[0] = lo_bf(yy.x) / (1.f + __expf(-v[0])); v[1] = hi_bf(yy.x) / (1.f + __expf(-v[1]));
        v[2] = lo_bf(yy.y) / (1.f + __expf(-v[2])); v[3] = hi_bf(yy.y) / (1.f + __expf(-v[3]));
        *(uint2*)(O + (size_t)row * 1024 + 512 + col) = pack4(v);
      }
    }
  }
};

namespace pg8 {
#define PG8_LAS __attribute__((address_space(3)))
typedef unsigned short bf16_t;
typedef short bf16x8 __attribute__((ext_vector_type(8)));
typedef float f32x4 __attribute__((ext_vector_type(4)));
typedef unsigned u32x4 __attribute__((ext_vector_type(4)));
constexpr int BM = 256, BK = 64, HALF = 128, HTB = HALF * BK * 2  , STAGE_BYTES = 8 * HTB, NXCD = 8, WGM = 8;

__host__ __device__ __forceinline__ int lds_byte(int r, int c) { const int st = (r >> 4) * 2 + (c >> 5), rr = r & 15, cc = c & 31, ob = rr * 64 + cc * 2; return st * 1024 + (ob ^ (((ob >> 9) & 1) << 5)); }
__host__ __device__ __forceinline__ void stage_rc(int b, int& R, int& C) { const int st = b / 1024, sb = b % 1024, swz = sb ^ (((sb >> 9) & 1) << 5); R = (st >> 1) * 16 + swz / 64; C = (st & 1) * 32 + (swz % 64) / 2; }
__host__ __device__ __forceinline__ int perm32(int rho) { const int n = rho >> 4, i = rho & 15; return 8 * (i >> 2) + 4 * n + (i & 3); }

struct Unit { int pm, pn; };
struct Gemm { const bf16_t* A; const bf16_t* Bt; int M, N, K; };
struct StaticOrder {
    int nM, nN, nwg, G, c;
    __host__ __device__ void init(int M, int N, int G_, int c_) { nM = M / BM; nN = N / BM; nwg = nM * nN; G = G_; c = c_; }
    __host__ __device__ bool next(int i, Unit& u) const {
        const long L = (long)i * G + c; if (L >= nwg) return false;
        int wgid = (int)L; { const int q = nwg / NXCD, r = nwg % NXCD, xcd = wgid % NXCD, off = wgid / NXCD; wgid = (xcd < r ? xcd * (q + 1) : r * (q + 1) + (xcd - r) * q) + off; }
        const int nig = WGM * nN, gid = wgid / nig, fm = gid * WGM, gsz = (nM - fm) < WGM ? (nM - fm) : WGM;
        u.pm = fm + ((wgid % nig) % gsz); u.pn = (wgid % nig) / gsz; return true;
    }
    __device__ __forceinline__ void a_ready(const Unit&) const {}
    __device__ __forceinline__ void done(const Unit&) const {}
};

template <class Epi, class Sched, bool ALIGN_EPI = false, bool SP2 = false>
__device__ __forceinline__ void gemm_phase(PG8_LAS unsigned char* lds, const Gemm g, const Sched& S, const Epi& E) {
    const int tid = threadIdx.x, wid = __builtin_amdgcn_readfirstlane(tid >> 6), lane = tid & 63, wr = wid >> 2, wc = wid & 3, fr = lane & 15, fq = lane >> 4;
    const int K = g.K, nt = K / BK;
    unsigned voffA[2], voffB[2];
#pragma unroll
    for (int i = 0; i < 2; ++i) { int R, C; stage_rc(tid * 16 + i * 8192, R, C); const int Rb = Epi::PERM ? ((R & ~31) + perm32(R & 31)) : R;
        voffA[i] = (unsigned)(R * K + C) * 2u; voffB[i] = (unsigned)(Rb * K + C) * 2u; }
    const size_t kstep = (size_t)(BK * 2);
    const size_t hstep = (size_t)HALF * K * 2;
    const size_t tstep = 2 * hstep;
    const unsigned ldsw = (unsigned)wid * 1024u;
    const int aoff = lds_byte(wr * 64 + fr, fq * 8), boff = lds_byte(wc * 32 + fr, fq * 8);
#define PG8_SA(b, h) (((b) * 2 + (h)) * HTB)
#define PG8_SB(b, h) ((4 + (b) * 2 + (h)) * HTB)
#define PG8_STAGE(bufoff, gbase, voff) do { _Pragma("unroll") for (int _i = 0; _i < 2; ++_i) \
        __builtin_amdgcn_global_load_lds((const unsigned*)((const char*)(gbase) + (voff)[_i]), (PG8_LAS unsigned*)(lds + (bufoff) + ldsw + _i * 8192), 16, 0, 0); } while (0)
#define PG8_LDA(dst, b, h) do { _Pragma("unroll") for (int m = 0; m < 4; ++m) _Pragma("unroll") for (int k = 0; k < 2; ++k) dst[m][k] = *(const PG8_LAS bf16x8*)(lds + PG8_SA(b, h) + aoff + m * 2048 + k * 1024); } while (0)
#define PG8_LDB(dst, b, h) do { _Pragma("unroll") for (int n = 0; n < 2; ++n) _Pragma("unroll") for (int k = 0; k < 2; ++k) dst[n][k] = *(const PG8_LAS bf16x8*)(lds + PG8_SB(b, h) + boff + n * 2048 + k * 1024); } while (0)
#define PG8_MMA(ai, bj, At, Bt) do { __builtin_amdgcn_s_setprio(1); _Pragma("unroll") for (int m = 0; m < 4; ++m) _Pragma("unroll") for (int n = 0; n < 2; ++n) _Pragma("unroll") for (int k = 0; k < 2; ++k) \
        acc[ai][bj][m][n] = __builtin_amdgcn_mfma_f32_16x16x32_bf16(Bt[n][k], At[m][k], acc[ai][bj][m][n], 0, 0, 0); __builtin_amdgcn_s_setprio(0); } while (0)
#define PG8_WAIT_V(n) asm volatile("s_waitcnt vmcnt(" #n ")" ::: "memory")
#define PG8_WAIT_L(n) asm volatile("s_waitcnt lgkmcnt(" #n ")" ::: "memory")
#define PG8_BAR __builtin_amdgcn_s_barrier()
#define PG8_SCHED __builtin_amdgcn_sched_barrier(0)
    Unit cur, nxt; int ui = 0;
    if (!S.next(0, cur)) return;
    f32x4 acc[2][2][4][2];
#pragma unroll
    for (int a = 0; a < 2; ++a)
#pragma unroll
        for (int b = 0; b < 2; ++b)
#pragma unroll
            for (int m = 0; m < 4; ++m)
#pragma unroll
                for (int n = 0; n < 2; ++n) acc[a][b][m][n] = (f32x4){0.f, 0.f, 0.f, 0.f};
    bf16x8 At[4][2], B0[2][2], B1[2][2];
    const char* cA = (const char*)g.A + (size_t)cur.pm * tstep; const char* cB = (const char*)g.Bt + (size_t)cur.pn * tstep;
    S.a_ready(cur);
    if constexpr (SP2) {
        PG8_STAGE(PG8_SB(0, 0), cB, voffB); PG8_STAGE(PG8_SB(0, 1), cB + hstep, voffB); PG8_STAGE(PG8_SA(0, 0), cA, voffA); PG8_STAGE(PG8_SA(0, 1), cA + hstep, voffA);
        if (wr == 1) PG8_BAR;
        PG8_WAIT_V(2); PG8_BAR;
        PG8_STAGE(PG8_SB(1, 0), cB + kstep, voffB); PG8_STAGE(PG8_SA(1, 0), cA + kstep, voffA); PG8_STAGE(PG8_SB(1, 1), cB + hstep + kstep, voffB);
        PG8_WAIT_V(6); PG8_BAR;
    } else {
        PG8_STAGE(PG8_SB(0, 0), cB, voffB); PG8_STAGE(PG8_SA(0, 0), cA, voffA); PG8_STAGE(PG8_SB(0, 1), cB + hstep, voffB); PG8_STAGE(PG8_SA(0, 1), cA + hstep, voffA);
        if (wr == 1) PG8_BAR;
        PG8_WAIT_V(4); PG8_BAR;
        PG8_STAGE(PG8_SB(1, 0), cB + kstep, voffB); PG8_STAGE(PG8_SA(1, 0), cA + kstep, voffA); PG8_STAGE(PG8_SB(1, 1), cB + hstep + kstep, voffB);
        PG8_WAIT_V(6); PG8_BAR;
    }
    for (;;) {
        const bool has_next = S.next(ui + 1, nxt);
        const char* nA = has_next ? (const char*)g.A + (size_t)nxt.pm * tstep : cA; const char* nB = has_next ? (const char*)g.Bt + (size_t)nxt.pn * tstep : cB;
        for (int t = 0; t < nt; t += 2) {
            const bool last = (t == nt - 2);
            const char* a1 = cA + (size_t)(t + 1) * kstep;
            const char* a2 = last ? nA : cA + (size_t)(t + 2) * kstep; const char* b2 = last ? nB : cB + (size_t)(t + 2) * kstep;
            const char* a3 = a2 + kstep; const char* b3 = b2 + kstep;
            if (last && has_next) S.a_ready(nxt);
            if constexpr (SP2) {
            PG8_LDB(B0, 0, 0); PG8_LDB(B1, 0, 1); PG8_SCHED; PG8_LDA(At, 0, 0); PG8_STAGE(PG8_SA(1, 1), a1 + hstep, voffA);
            PG8_WAIT_V(8); PG8_WAIT_L(0); PG8_BAR; PG8_MMA(0, 0, At, B0); PG8_MMA(0, 1, At, B1); PG8_BAR; PG8_SCHED;
            PG8_LDA(At, 0, 1); PG8_STAGE(PG8_SB(0, 0), b2, voffB); PG8_STAGE(PG8_SB(0, 1), b2 + hstep, voffB); PG8_STAGE(PG8_SA(0, 0), a2, voffA);
            PG8_WAIT_V(8); PG8_WAIT_L(0); PG8_BAR; PG8_MMA(1, 0, At, B0); PG8_MMA(1, 1, At, B1); PG8_BAR; PG8_SCHED;
            PG8_LDB(B0, 1, 0); PG8_LDB(B1, 1, 1); PG8_SCHED; PG8_LDA(At, 1, 0); PG8_STAGE(PG8_SA(0, 1), a2 + hstep, voffA);
            PG8_WAIT_V(8); PG8_WAIT_L(0); PG8_BAR; PG8_MMA(0, 0, At, B0); PG8_MMA(0, 1, At, B1); PG8_BAR; PG8_SCHED;
            PG8_LDA(At, 1, 1); PG8_STAGE(PG8_SB(1, 0), b3, voffB); PG8_STAGE(PG8_SB(1, 1), b3 + hstep, voffB); PG8_STAGE(PG8_SA(1, 0), a3, voffA);
            PG8_WAIT_V(8); PG8_WAIT_L(0); PG8_BAR; PG8_MMA(1, 0, At, B0); PG8_MMA(1, 1, At, B1); PG8_BAR; PG8_SCHED;
            } else {
            PG8_LDB(B0, 0, 0); PG8_SCHED; PG8_LDA(At, 0, 0); PG8_STAGE(PG8_SA(1, 1), a1 + hstep, voffA);
            PG8_WAIT_L(8); PG8_BAR; PG8_WAIT_L(0); PG8_MMA(0, 0, At, B0); PG8_BAR; PG8_SCHED;
            PG8_LDB(B1, 0, 1); PG8_STAGE(PG8_SB(0, 0), b2, voffB);
            PG8_BAR; PG8_WAIT_L(0); PG8_MMA(0, 1, At, B1); PG8_BAR;
            PG8_LDA(At, 0, 1); PG8_STAGE(PG8_SA(0, 0), a2, voffA);
            PG8_BAR; PG8_WAIT_L(0); PG8_MMA(1, 0, At, B0); PG8_BAR; PG8_SCHED;
            PG8_STAGE(PG8_SB(0, 1), b2 + hstep, voffB);
            PG8_WAIT_V(6); PG8_BAR; PG8_MMA(1, 1, At, B1); PG8_BAR;
            PG8_LDB(B0, 1, 0); PG8_SCHED; PG8_LDA(At, 1, 0); PG8_STAGE(PG8_SA(0, 1), a2 + hstep, voffA);
            PG8_WAIT_L(8); PG8_BAR; PG8_WAIT_L(0); PG8_MMA(0, 0, At, B0); PG8_BAR; PG8_SCHED;
            PG8_LDB(B1, 1, 1); PG8_STAGE(PG8_SB(1, 0), b3, voffB);
            PG8_BAR; PG8_WAIT_L(0); PG8_MMA(0, 1, At, B1); PG8_BAR;
            PG8_LDA(At, 1, 1); PG8_STAGE(PG8_SA(1, 0), a3, voffA);
            PG8_BAR; PG8_WAIT_L(0); PG8_MMA(1, 0, At, B0); PG8_BAR; PG8_SCHED;
            PG8_STAGE(PG8_SB(1, 1), b3 + hstep, voffB);
            PG8_WAIT_V(6); PG8_BAR; PG8_MMA(1, 1, At, B1); PG8_BAR;
            }
        }
        if constexpr (ALIGN_EPI) { if (wr == 0) PG8_BAR; }
        if constexpr (!Epi::AFTER_DRAIN) { E(acc, cur, wr, wc, fr, fq); S.done(cur); }
        if (!has_next) break;
#pragma unroll
        for (int a = 0; a < 2; ++a)
#pragma unroll
            for (int b = 0; b < 2; ++b)
#pragma unroll
                for (int m = 0; m < 4; ++m)
#pragma unroll
                    for (int n = 0; n < 2; ++n) acc[a][b][m][n] = (f32x4){0.f, 0.f, 0.f, 0.f};
        cur = nxt; cA = nA; cB = nB; ++ui;
        if constexpr (ALIGN_EPI) { if (wr == 1) PG8_BAR; }
    }
    PG8_WAIT_V(0);
    if constexpr (!ALIGN_EPI) { if (wr == 0) PG8_BAR; }
    PG8_BAR;
    if constexpr (Epi::AFTER_DRAIN) { E.fused(acc, cur, wr, wc, fr, fq, lds, wid, lane); S.done(cur); }
#undef PG8_SA
#undef PG8_SB
#undef PG8_STAGE
#undef PG8_LDA
#undef PG8_LDB
#undef PG8_MMA
#undef PG8_WAIT_V
#undef PG8_WAIT_L
#undef PG8_BAR
#undef PG8_SCHED
}
}

struct ElBf16 { bf16_t* O; int ld; DI void operator()(int row, int col, f32x4 v) const { *(uint2*)(O + (size_t)row * ld + col) = pack4(v); } };
struct ElRelu2 { bf16_t* O; int ld; DI void operator()(int row, int col, f32x4 v) const {
#pragma unroll
  for (int j = 0; j < 4; ++j) { float t = fmaxf(v[j], 0.f); v[j] = t * t; }
  *(uint2*)(O + (size_t)row * ld + col) = pack4(v); } };
struct ElResid { const float* X; float* Y; DI void operator()(int row, int col, f32x4 v) const {
  const size_t o = (size_t)row * DM + col; const f32x4 x = *(const f32x4*)(X + o); *(f32x4*)(Y + o) = x * ALPHA + v; } };
struct ElH1 { bf16_t* H1; bf16_t* VT; float* WI; bf16_t* Ug; DI void operator()(int row, int col, f32x4 v) const {
  if (col < 1024 || (col >= 1536 && col < 2112)) *(uint2*)(H1 + (size_t)row * LD_H1 + col) = pack4(v);
  else if (col < 1536) {
    const int hc = col - 1024, h = hc >> 6, e = hc & 63, b = row >> 13, l = row & 8191;
#pragma unroll
    for (int j = 0; j < 4; ++j) VT[((size_t)((b * 8 + h) * 64 + e + j)) * SEQ + l] = f2bf(v[j]);
  } else if (col < 2120) { *(f32x4*)(WI + (size_t)row * 8 + (col - 2112)) = v * 0.35355339059327373f; }
  else if (col < 2632) { const int ch = col - 2120, g = ch >> 4, ci = ch & 15;
    *(uint2*)(Ug + ((size_t)(g * 1024 + (row >> 5))) * 640 + (row & 31) * 16 + ci) = pack4(v); } } };
template <class El> struct EpiEl {
  El el;
  DI void operator()(const f32x4 (&acc)[4][4], int mw, int nw, int fr, int fq) const {
#pragma unroll
    for (int mi = 0; mi < 4; ++mi)
#pragma unroll
      for (int ni = 0; ni < 4; ++ni) el(mw + mi * 16 + fr, nw + ni * 16 + fq * 4, acc[mi][ni]);
  }
};
template <class El> struct P8El {
  static constexpr bool PERM = false, AFTER_DRAIN = false;
  El el;
  DI void operator()(const f32x4 (&acc)[2][2][4][2], const pg8::Unit& u, int wr, int wc, int fr, int fq) const {
#pragma unroll
    for (int ai = 0; ai < 2; ++ai)
#pragma unroll
      for (int m = 0; m < 4; ++m)
#pragma unroll
        for (int bj = 0; bj < 2; ++bj)
#pragma unroll
          for (int n = 0; n < 2; ++n)
            el(u.pm * 256 + ai * 128 + wr * 64 + m * 16 + fr, u.pn * 256 + bj * 128 + wc * 32 + n * 16 + fq * 4, acc[ai][bj][m][n]);
  }
};

struct El8Bf16 { bf16_t* O; int ld; DI void operator()(int row, int col, f32x4 a, f32x4 b) const {
  uint4 w; w.x = pack2(a[0], a[1]); w.y = pack2(a[2], a[3]); w.z = pack2(b[0], b[1]); w.w = pack2(b[2], b[3]); *(uint4*)(O + (size_t)row * ld + col) = w; } };
struct El8Relu2 { bf16_t* O; int ld; DI void operator()(int row, int col, f32x4 a, f32x4 b) const {
#pragma unroll
  for (int j = 0; j < 4; ++j) { float t = fmaxf(a[j], 0.f); a[j] = t * t; float u = fmaxf(b[j], 0.f); b[j] = u * u; }
  uint4 w; w.x = pack2(a[0], a[1]); w.y = pack2(a[2], a[3]); w.z = pack2(b[0], b[1]); w.w = pack2(b[2], b[3]); *(uint4*)(O + (size_t)row * ld + col) = w; } };
struct El8ResidF { const float* X; float* Y; DI void operator()(int row, int col, f32x4 a, f32x4 b) const {
  const size_t o = (size_t)row * DM + col; const f32x4 x0 = *(const f32x4*)(X + o), x1 = *(const f32x4*)(X + o + 4);
  *(f32x4*)(Y + o) = x0 * ALPHA + a; *(f32x4*)(Y + o + 4) = x1 * ALPHA + b; } };
struct El8ResidB { const bf16_t* X; float* Y; DI void operator()(int row, int col, f32x4 a, f32x4 b) const {
  const size_t o = (size_t)row * DM + col; const uint4 x = *(const uint4*)(X + o);
  const f32x4 x0 = {lo_bf(x.x), hi_bf(x.x), lo_bf(x.y), hi_bf(x.y)}, x1 = {lo_bf(x.z), hi_bf(x.z), lo_bf(x.w), hi_bf(x.w)};
  *(f32x4*)(Y + o) = x0 * ALPHA + a; *(f32x4*)(Y + o + 4) = x1 * ALPHA + b; } };
template <class El> struct P8El8 {
  static constexpr bool PERM = true, AFTER_DRAIN = false;
  El el;
  DI void operator()(const f32x4 (&acc)[2][2][4][2], const pg8::Unit& u, int wr, int wc, int fr, int fq) const {
#pragma unroll
    for (int ai = 0; ai < 2; ++ai)
#pragma unroll
      for (int m = 0; m < 4; ++m)
#pragma unroll
        for (int bj = 0; bj < 2; ++bj)
          el(u.pm * 256 + ai * 128 + wr * 64 + m * 16 + fr, u.pn * 256 + bj * 128 + wc * 32 + fq * 8, acc[ai][bj][m][0], acc[ai][bj][m][1]);
  }
};
template <class El> DI void big_gemm8(char* lds, const bf16_t* A, const bf16_t* Bt, int N, int K, const El& el) {
  pg8::Gemm g{A, Bt, NTOK, N, K}; pg8::StaticOrder S; S.init(NTOK, N, (int)gridDim.x, (int)blockIdx.x);
  P8El8<El> E{el};
  pg8::gemm_phase<P8El8<El>, pg8::StaticOrder, true, true>((PG8_LAS unsigned char*)lds, g, S, E);
  __syncthreads();
}
struct P8H1 {
  static constexpr bool PERM = true, AFTER_DRAIN = false;
  bf16_t* H1; bf16_t* VT;
  DI void operator()(const f32x4 (&acc)[2][2][4][2], const pg8::Unit& u, int wr, int wc, int fr, int fq) const {
    if (u.pn == 4 || u.pn == 5) {
#pragma unroll
      for (int ai = 0; ai < 2; ++ai)
#pragma unroll
        for (int m = 0; m < 4; ++m) {
          const int row = u.pm * 256 + ai * 128 + wr * 64 + m * 16 + fr, b = row >> 13, l = row & 8191;
#pragma unroll
          for (int bj = 0; bj < 2; ++bj) {
            const int hc = (u.pn - 4) * 256 + bj * 128 + wc * 32 + fq * 8, h = hc >> 6, e = hc & 63;
            bf16_t* vp = VT + ((size_t)((b * 8 + h) * 64 + e)) * SEQ + l;
            const f32x4 v0 = acc[ai][bj][m][0], v1 = acc[ai][bj][m][1];
            vp[0] = f2bf(v0[0]); vp[SEQ] = f2bf(v0[1]); vp[2 * SEQ] = f2bf(v0[2]); vp[3 * SEQ] = f2bf(v0[3]);
            vp[4 * SEQ] = f2bf(v1[0]); vp[5 * SEQ] = f2bf(v1[1]); vp[6 * SEQ] = f2bf(v1[2]); vp[7 * SEQ] = f2bf(v1[3]);
          }
        }
    } else {
      El8Bf16 st{H1, LD_H1};
#pragma unroll
      for (int ai = 0; ai < 2; ++ai)
#pragma unroll
        for (int m = 0; m < 4; ++m)
#pragma unroll
          for (int bj = 0; bj < 2; ++bj)
            st(u.pm * 256 + ai * 128 + wr * 64 + m * 16 + fr, u.pn * 256 + bj * 128 + wc * 32 + fq * 8, acc[ai][bj][m][0], acc[ai][bj][m][1]);
    }
  }
};
template <class El> DI void big_gemm(char* lds, const bf16_t* A, const bf16_t* Bt, int N, int K, const El& el) {
  pg8::Gemm g{A, Bt, NTOK, N, K}; pg8::StaticOrder S; S.init(NTOK, N, (int)gridDim.x, (int)blockIdx.x);
  P8El<El> E{el};
  pg8::gemm_phase<P8El<El>, pg8::StaticOrder, true, true>((PG8_LAS unsigned char*)lds, g, S, E);
  __syncthreads();
}
struct TJob { const float* W; const float* sc; bf16_t* Wt; int K, N, k0, n0; };
DI void tjob_decode(const Params& p, int t, TJob& j) {
  char* ws = p.ws; int r = t, nn; j.sc = nullptr;
  if (r < 512) { j.W = p.in[2]; j.K = 1024; j.N = 1968; nn = 32; j.Wt = (bf16_t*)(ws + OFF_WT_IN0); }
  else if ((r -= 512) < 256) { j.W = p.in[10]; j.K = 1024; j.N = 1024; nn = 16; j.Wt = (bf16_t*)(ws + OFF_WT_OUT0); }
  else if ((r -= 256) < 1024) { j.W = p.in[13]; j.K = 1024; j.N = 4096; nn = 64; j.Wt = (bf16_t*)(ws + OFF_WT_10); }
  else if ((r -= 1024) < 1024) { j.W = p.in[14]; j.K = 4096; j.N = 1024; nn = 16; j.Wt = (bf16_t*)(ws + OFF_WT_20); }
  else if ((r -= 1024) < 672) { j.W = p.in[17]; j.K = 1024; j.N = 2632; nn = 42; j.Wt = (bf16_t*)(ws + OFF_WT_IN1); }
  else if ((r -= 672) < 256) { j.W = p.in[28]; j.K = 1024; j.N = 1024; nn = 16; j.Wt = (bf16_t*)(ws + OFF_WT_OUT1); }
  else if ((r -= 256) < 1024) { j.W = p.in[31]; j.K = 1024; j.N = 4096; nn = 64; j.Wt = (bf16_t*)(ws + OFF_WT_11); }
  else if ((r -= 1024) < 1024) { j.W = p.in[32]; j.K = 4096; j.N = 1024; nn = 16; j.Wt = (bf16_t*)(ws + OFF_WT_21); }
  else if ((r -= 1024) < 48) { j.W = p.in[7]; j.K = 256; j.N = 768; nn = 12; j.Wt = (bf16_t*)(ws + OFF_WT_UQ); j.sc = p.in[6]; }
  else if ((r -= 48) < 32) { j.W = p.in[9]; j.K = 128; j.N = 1024; nn = 16; j.Wt = (bf16_t*)(ws + OFF_WT_UKV); j.sc = p.in[8]; }
  else { r -= 32; j.W = p.in[26]; j.K = 512; j.N = 512; nn = 8; j.Wt = (bf16_t*)(ws + OFF_WT_GLU); }
  j.k0 = (r / nn) * 64; j.n0 = (r % nn) * 64;
}
DI void tjob_load(const TJob& j, float (&v)[8]) {
  const int tid = threadIdx.x, jj = tid & 63, i = tid >> 6, n = j.n0 + jj;
#pragma unroll
  for (int rr = 0; rr < 8; ++rr) {
    const int k = j.k0 + i + 8 * rr;
    float x = (n < j.N) ? j.W[(size_t)k * j.N + n] : 0.f;
    if (j.sc) x *= j.sc[k];
    v[rr] = x;
  }
}
DI void tjob_store(const TJob& j, const float (&v)[8], float* tile) {
  const int tid = threadIdx.x, jj = tid & 63, i = tid >> 6;
#pragma unroll
  for (int rr = 0; rr < 8; ++rr) tile[(i + 8 * rr) * 65 + jj] = v[rr];
  __syncthreads();
  const int n = tid >> 3, ks = (tid & 7) * 8;
  uint4 o;
  o.x = pack2(tile[(ks + 0) * 65 + n], tile[(ks + 1) * 65 + n]); o.y = pack2(tile[(ks + 2) * 65 + n], tile[(ks + 3) * 65 + n]);
  o.z = pack2(tile[(ks + 4) * 65 + n], tile[(ks + 5) * 65 + n]); o.w = pack2(tile[(ks + 6) * 65 + n], tile[(ks + 7) * 65 + n]);
  *(uint4*)(j.Wt + (size_t)(j.n0 + n) * j.K + j.k0 + ks) = o;
  __syncthreads();
}

DI void phase_prep(const Params& p, char* lds) {
  float* tile = (float*)lds;
  char* ws = p.ws;
  constexpr int NT = 512 + 256 + 1024 + 1024 + 672 + 256 + 1024 + 1024 + 48 + 32 + 64;
  {
    TJob cur, nxt; float vc[8], vn[8];
    int t = blockIdx.x;
    if (t < NT) { tjob_decode(p, t, cur); tjob_load(cur, vc); }
    for (; t < NT; t += gridDim.x) {
      const bool has = (t + (int)gridDim.x) < NT;
      if (has) { tjob_decode(p, t + gridDim.x, nxt); tjob_load(nxt, vn); }
      tjob_store(cur, vc, tile);
      if (has) {
        cur = nxt;
#pragma unroll
        for (int rr = 0; rr < 8; ++rr) vc[rr] = vn[rr];
      }
    }
  }
  {
    const float* x = p.in[0]; bf16_t* xb = (bf16_t*)(ws + OFF_XB);
    const size_t n4 = (size_t)NTOK * DM / 4, gsz = (size_t)gridDim.x * 512;
    for (size_t i = (size_t)blockIdx.x * 512 + threadIdx.x; i < n4; i += gsz) {
      f32x4 v = *(const f32x4*)(x + i * 4);
      *(uint2*)(xb + i * 4) = pack4(v);
    }
  }
  {
    float* apow = (float*)(ws + OFF_APOW); float* bbar = (float*)(ws + OFF_BBAR);
    const int gsz = gridDim.x * 512, gid = blockIdx.x * 512 + threadIdx.x;
    for (int i = gid; i < 32 * 33 * 64; i += gsz) {
      const int pp = i & 63, tau = (i >> 6) % 33, g = i / (64 * 33);
      const float dt = expf(p.in[25][g]);
      const float lre = fminf(p.in[18][g * 64 + pp], -1e-4f), lim = p.in[19][g * 64 + pp];
      const float mag = expf(lre * dt * (float)tau);
      const double th = (double)(lim * dt) * (double)tau;
      apow[2 * i] = mag * (float)cos(th); apow[2 * i + 1] = mag * (float)sin(th);
    }
    for (int i = gid; i < 32 * 64 * 16; i += gsz) {
      const int ci = i & 15, pp = (i >> 4) & 63, g = i >> 10;
      const float dt = expf(p.in[25][g]);
      const float lre = fminf(p.in[18][g * 64 + pp], -1e-4f), lim = p.in[19][g * 64 + pp];
      const float mag = expf(lre * dt);
      const float are = mag * cosf(lim * dt), aim = mag * sinf(lim * dt);
      const float den = lre * lre + lim * lim, nr = are - 1.f, ni = aim;
      const float cre = (nr * lre + ni * lim) / den, cim = (ni * lre - nr * lim) / den;
      const float bre = p.in[20][i], bim = p.in[21][i];
      bbar[2 * i] = cre * bre - cim * bim; bbar[2 * i + 1] = cre * bim + cim * bre;
    }
  }
}

DI void s5_ktab(const Params& p) {
  const float* apow = (const float*)(p.ws + OFF_APOW); const float* bbar = (const float*)(p.ws + OFF_BBAR);
  float* ktab = (float*)(p.ws + OFF_KTAB);
  const int gsz = gridDim.x * 512, gid = blockIdx.x * 512 + threadIdx.x;
  for (int i = gid; i < 32 * 32 * 256; i += gsz) {
    const int ci = i & 15, co = (i >> 4) & 15, tau = (i >> 8) & 31, g = i >> 13;
    float s = 0.f;
    for (int pp = 0; pp < 64; ++pp) {
      const float cr = p.in[22][(g * 16 + co) * 64 + pp], cim = p.in[23][(g * 16 + co) * 64 + pp];
      const float ar = apow[2 * ((g * 33 + tau) * 64 + pp)], ai = apow[2 * ((g * 33 + tau) * 64 + pp) + 1];
      const float br = bbar[2 * ((g * 64 + pp) * 16 + ci)], bi = bbar[2 * ((g * 64 + pp) * 16 + ci) + 1];
      const float xr = ar * br - ai * bi, xi = ar * bi + ai * br;
      s += cr * xr - cim * xi;
    }
    ktab[i] = s;
  }
}
DI void s5_expand(const Params& p) {
  const float* apow = (const float*)(p.ws + OFF_APOW); const float* bbar = (const float*)(p.ws + OFF_BBAR);
  const float* ktab = (const float*)(p.ws + OFF_KTAB);
  bf16_t* TF = (bf16_t*)((char*)p.out + OUT_TF); bf16_t* E = (bf16_t*)((char*)p.out + OUT_E);
  const int gsz = gridDim.x * 512, gid = blockIdx.x * 512 + threadIdx.x;
#pragma unroll 4
  for (int i = gid; i < 32 * 512 * 640; i += gsz) {
    const int k = i % 640, n = (i / 640) & 511, g = i / (640 * 512);
    const int ii = n >> 4, co = n & 15;
    float v;
    if (k < 512) { const int j = k >> 4, ci = k & 15; v = (j <= ii) ? ktab[((g * 32 + (ii - j)) * 16 + co) * 16 + ci] : 0.f; }
    else {
      const int pp = (k - 512) >> 1, ri = k & 1;
      const float cr = p.in[22][(g * 16 + co) * 64 + pp], cim = p.in[23][(g * 16 + co) * 64 + pp];
      const float ar = apow[2 * ((g * 33 + ii + 1) * 64 + pp)], ai = apow[2 * ((g * 33 + ii + 1) * 64 + pp) + 1];
      v = ri ? -(cr * ai + cim * ar) : (cr * ar - cim * ai);
    }
    TF[i] = f2bf(v);
  }
#pragma unroll 4
  for (int i = gid; i < 32 * 128 * 512; i += gsz) {
    const int k = i & 511, n = (i >> 9) & 127, g = i >> 16;
    const int j = k >> 4, ci = k & 15, pp = n >> 1, ri = n & 1;
    const float ar = apow[2 * ((g * 33 + (31 - j)) * 64 + pp)], ai = apow[2 * ((g * 33 + (31 - j)) * 64 + pp) + 1];
    const float br = bbar[2 * ((g * 64 + pp) * 16 + ci)], bi = bbar[2 * ((g * 64 + pp) * 16 + ci) + 1];
    E[i] = f2bf(ri ? (ar * bi + ai * br) : (ar * br - ai * bi));
  }
}

DI void phase_ln(const float* __restrict__ X, float* __restrict__ Yf, bf16_t* __restrict__ Yb, const float* __restrict__ g, const float* __restrict__ bta) {
  const int lane = threadIdx.x & 63, wid = threadIdx.x >> 6;
  for (int row = blockIdx.x * 8 + wid; row < NTOK; row += gridDim.x * 8) {
    f32x4 v[4]; float s = 0.f;
#pragma unroll
    for (int i = 0; i < 4; ++i) { v[i] = *(const f32x4*)(X + (size_t)row * DM + i * 256 + lane * 4); s += (v[i][0] + v[i][1]) + (v[i][2] + v[i][3]); }
#pragma unroll
    for (int o = 32; o >= 1; o >>= 1) s += __shfl_xor(s, o);
    const float mu = s * (1.f / 1024.f); float q = 0.f;
#pragma unroll
    for (int i = 0; i < 4; ++i) { f32x4 d = v[i] - mu; q += (d[0] * d[0] + d[1] * d[1]) + (d[2] * d[2] + d[3] * d[3]); }
#pragma unroll
    for (int o = 32; o >= 1; o >>= 1) q += __shfl_xor(q, o);
    const float rstd = rsqrtf(q * (1.f / 1024.f) + LN_EPS);
#pragma unroll
    for (int i = 0; i < 4; ++i) {
      const int c = i * 256 + lane * 4;
      f32x4 gg = *(const f32x4*)(g + c), bb = *(const f32x4*)(bta + c);
      f32x4 o = (v[i] - mu) * rstd * gg + bb;
      if (Yf) *(f32x4*)(Yf + (size_t)row * DM + c) = o;
      if (Yb) *(uint2*)(Yb + (size_t)row * DM + c) = pack4(o);
    }
  }
}

template <int DQ, bool MASKED>
DI void attn_item(const bf16_t* __restrict__ Q, int ldq, const bf16_t* __restrict__ Kp, int ldk, const bf16_t* __restrict__ VT,
                  bf16_t* __restrict__ O, int ocol, const unsigned* __restrict__ mask, int b, int h, int qb, float scale_log2, char* lds) {
  constexpr int KRS = DQ * 2 + 16, VRS = 136, NS = DQ / 16, KP = DQ / 8;
  constexpr int KBUF = 64 * KRS, VBUF = 64 * VRS;
  const int tid = threadIdx.x, lane = tid & 63, w = tid >> 6, c = lane & 31, hh = lane >> 5;
  const int q0 = qb * 256, qw0 = q0 + w * 32;
  const size_t tokbase = (size_t)b * SEQ;
  char* sK0 = lds; char* sK1 = lds + KBUF; char* sV0 = lds + 2 * KBUF; char* sV1 = sV0 + VBUF;
  bf16x8 qf[NS];
#pragma unroll
  for (int s = 0; s < NS; ++s) qf[s] = *(const bf16x8*)(Q + (tokbase + qw0 + c) * ldq + h * DQ + s * 16 + hh * 8);
  const bf16_t* Kbase = Kp + tokbase * ldk + h * DQ;
  const bf16_t* Vbase = VT + (size_t)((b * 8 + h) * 64) * SEQ;
  const int ntiles = (q0 + 256) / 64;
  uint4 rk0, rk1, rv; uint2 rm = {0u, 0u};
  char* sM0 = sV1 + VBUF; char* sM1 = sM0 + 2048;
  const unsigned* mrow = MASKED ? mask + (tokbase + q0 + (tid & 255)) * 256 : nullptr;
  const int kr0 = tid / KP, kc0 = tid % KP, kr1 = (tid + 512) / KP, kc1 = (tid + 512) % KP;
  const bool has1 = (tid + 512) < 64 * KP;
  const int vr = tid >> 3, vc = tid & 7;
  auto gl = [&](int t) {
    rk0 = *(const uint4*)(Kbase + (size_t)(t * 64 + kr0) * ldk + kc0 * 8);
    if (has1) rk1 = *(const uint4*)(Kbase + (size_t)(t * 64 + kr1) * ldk + kc1 * 8);
    rv = *(const uint4*)(Vbase + (size_t)vr * SEQ + t * 64 + vc * 8);
    if (MASKED) { if (tid < 256) rm = *(const uint2*)(mrow + 2 * t); }
  };
  auto sw = [&](char* sK, char* sV) {
    if (MASKED) { if (tid < 256) *(uint2*)((sK == sK0 ? sM0 : sM1) + tid * 8) = rm; }
    *(uint4*)(sK + kr0 * KRS + kc0 * 16) = rk0;
    if (has1) *(uint4*)(sK + kr1 * KRS + kc1 * 16) = rk1;
    *(uint2*)(sV + vr * VRS + vc * 16) = (uint2){rv.x, rv.y};
    *(uint2*)(sV + vr * VRS + vc * 16 + 8) = (uint2){rv.z, rv.w};
  };
  f32x16 oacc[2];
#pragma unroll
  for (int i = 0; i < 16; ++i) { oacc[0][i] = 0.f; oacc[1][i] = 0.f; }
  float mrun = -1e30f, lrun = 0.f;
  gl(0); sw(sK0, sV0);
  if (ntiles > 1) gl(1);
  __syncthreads();
  for (int t = 0; t < ntiles; ++t) {
    char* sK = (t & 1) ? sK1 : sK0; char* sV = (t & 1) ? sV1 : sV0;
    const int kt0 = t * 64;
    if (kt0 <= qw0 + 31) {
      f32x16 sacc[2];
#pragma unroll
      for (int rb = 0; rb < 2; ++rb) {
        bf16x8 kf[NS];
#pragma unroll
        for (int s = 0; s < NS; ++s) kf[s] = *(const bf16x8*)(sK + (rb * 32 + c) * KRS + s * 32 + hh * 16);
        __builtin_amdgcn_sched_barrier(0);
#pragma unroll
        for (int i = 0; i < 16; ++i) sacc[rb][i] = 0.f;
#pragma unroll
        for (int s = 0; s < NS; ++s) sacc[rb] = MFMA32(kf[s], qf[s], sacc[rb]);
      }
      constexpr float NEGM = -3.0e38f;
      if (MASKED) {
        const uint2 mm = *(const uint2*)(((t & 1) ? sM1 : sM0) + (w * 32 + c) * 8);
#pragma unroll
        for (int rb = 0; rb < 2; ++rb)
#pragma unroll
          for (int i = 0; i < 16; ++i) {
            const unsigned mb = (unsigned)__builtin_amdgcn_sbfe((int)(rb ? mm.y : mm.x), crow(i, hh), 1);
            sacc[rb][i] = __uint_as_float((__float_as_uint(sacc[rb][i]) & mb) | (__float_as_uint(NEGM) & ~mb));
          }
      } else if (kt0 + 63 > qw0) {
#pragma unroll
        for (int rb = 0; rb < 2; ++rb)
#pragma unroll
          for (int i = 0; i < 16; ++i) if (kt0 + rb * 32 + crow(i, hh) > qw0 + c) sacc[rb][i] = NEGM;
      }
      float mx = NEGM;
#pragma unroll
      for (int rb = 0; rb < 2; ++rb)
#pragma unroll
        for (int i = 0; i < 16; ++i) mx = fmaxf(mx, sacc[rb][i]);
      mx = fmaxf(mx, __shfl_xor(mx, 32));
      const float mnew = fmaxf(mrun, mx * scale_log2);
      if (__any(mnew > mrun)) {
        const float alpha = __builtin_amdgcn_exp2f(mrun - mnew);
        mrun = mnew; lrun *= alpha;
#pragma unroll
        for (int i = 0; i < 16; ++i) { oacc[0][i] *= alpha; oacc[1][i] *= alpha; }
      }
      float ps = 0.f;
#pragma unroll
      for (int rb = 0; rb < 2; ++rb)
#pragma unroll
        for (int i = 0; i < 16; ++i) {
          const float pv = __builtin_amdgcn_exp2f(fmaf(sacc[rb][i], scale_log2, -mrun));
          sacc[rb][i] = pv; ps += pv;
        }
      lrun += ps;
#pragma unroll
      for (int kb = 0; kb < 2; ++kb) {
        bf16x8 va[2][2];
#pragma unroll
        for (int s = 0; s < 2; ++s)
#pragma unroll
          for (int eb = 0; eb < 2; ++eb) {
            const char* vp = sV + (eb * 32 + c) * VRS + (kb * 32 + s * 16 + hh * 4) * 2;
            const s16x4 a0 = *(const s16x4*)vp, a1 = *(const s16x4*)(vp + 16);
            va[s][eb] = __builtin_shufflevector(a0, a1, 0, 1, 2, 3, 4, 5, 6, 7);
          }
#pragma unroll
        for (int s = 0; s < 2; ++s) {
          const unsigned u0 = pack2(sacc[kb][8 * s + 0], sacc[kb][8 * s + 1]), u1 = pack2(sacc[kb][8 * s + 2], sacc[kb][8 * s + 3]);
          const unsigned u2 = pack2(sacc[kb][8 * s + 4], sacc[kb][8 * s + 5]), u3 = pack2(sacc[kb][8 * s + 6], sacc[kb][8 * s + 7]);
          const u32x4 uu = {u0, u1, u2, u3};
          const bf16x8 pb = __builtin_bit_cast(bf16x8, uu);
#pragma unroll
          for (int eb = 0; eb < 2; ++eb) oacc[eb] = MFMA32(va[s][eb], pb, oacc[eb]);
        }
      }
    }
    if (t + 1 < ntiles) sw((t & 1) ? sK0 : sK1, (t & 1) ? sV0 : sV1);
    if (t + 2 < ntiles) gl(t + 2);
    __syncthreads();
  }
  const float ltot = lrun + __shfl_xor(lrun, 32);
  const float inv = 1.f / ltot;
  bf16_t* orow = O + (tokbase + qw0 + c) * 1024 + ocol + h * 64;
#pragma unroll
  for (int eb = 0; eb < 2; ++eb)
#pragma unroll
    for (int g4 = 0; g4 < 4; ++g4) {
      f32x4 v = {oacc[eb][4 * g4] * inv, oacc[eb][4 * g4 + 1] * inv, oacc[eb][4 * g4 + 2] * inv, oacc[eb][4 * g4 + 3] * inv};
      *(uint2*)(orow + eb * 32 + 8 * g4 + 4 * hh) = pack4(v);
    }
}

constexpr int GL_CUM = 0;
constexpr int GL_GLR = 16640;
constexpr int GL_SEG = 20736;
constexpr int GL_A = 22784;
constexpr int GL_B = 32000;
constexpr int GL_VT = 41216;
constexpr int GL_SP = 59648;
constexpr int GL_SSQ = 78080;

DI void gla_cum(const Params& p, const bf16_t* H0, int tok0, int h, char* lds) {
  const int tid = threadIdx.x;
  float* cum = (float*)(lds + GL_CUM); float* glr = (float*)(lds + GL_GLR); float* seg = (float*)(lds + GL_SEG);
  for (int i = tid; i < 64 * 16; i += 512) glr[i] = bf2f(H0[(size_t)(tok0 + (i >> 4)) * LD_H0 + 1024 + (i & 15)]);
  __syncthreads();
  {
    const int tok = tid >> 3, d0 = (tid & 7) * 8;
    float g[8];
#pragma unroll
    for (int j = 0; j < 8; ++j) g[j] = p.in[4][h * 64 + d0 + j];
#pragma unroll
    for (int r = 0; r < 16; ++r) {
      const float gv = glr[tok * 16 + r];
      const f32x4 w0 = *(const f32x4*)(p.in[3] + r * 256 + h * 64 + d0), w1 = *(const f32x4*)(p.in[3] + r * 256 + h * 64 + d0 + 4);
#pragma unroll
      for (int j = 0; j < 4; ++j) { g[j] += gv * w0[j]; g[4 + j] += gv * w1[j]; }
    }
#pragma unroll
    for (int j = 0; j < 8; ++j) {
      const float x = g[j];
      const float ls = fminf(x, 0.f) - log1pf(expf(-fabsf(x)));
      cum[tok * 65 + d0 + j] = ls * (1.f / 16.f);
    }
  }
  __syncthreads();
  {
    const int d = tid & 63, sg = tid >> 6;
    float run = 0.f;
#pragma unroll
    for (int j = 0; j < 8; ++j) { run += cum[(sg * 8 + j) * 65 + d]; cum[(sg * 8 + j) * 65 + d] = run; }
    seg[sg * 64 + d] = run;
    __syncthreads();
    float off = 0.f;
    for (int s2 = 0; s2 < sg; ++s2) off += seg[s2 * 64 + d];
#pragma unroll
    for (int j = 0; j < 8; ++j) cum[(sg * 8 + j) * 65 + d] += off;
  }
  __syncthreads();
}

DI void gla_load_vt(const bf16_t* H0, int tok0, int h, char* lds) {
  const int tid = threadIdx.x;
  for (int i = tid; i < 64 * 16; i += 512) {
    const int tok = i >> 4, e0 = (i & 15) * 8;
    const uint4 v = *(const uint4*)(H0 + (size_t)(tok0 + tok) * LD_H0 + 512 + h * 128 + e0);
    bf16_t* vt = (bf16_t*)(lds + GL_VT);
    vt[(e0 + 0) * 72 + tok] = (bf16_t)(v.x & 0xffff); vt[(e0 + 1) * 72 + tok] = (bf16_t)(v.x >> 16);
    vt[(e0 + 2) * 72 + tok] = (bf16_t)(v.y & 0xffff); vt[(e0 + 3) * 72 + tok] = (bf16_t)(v.y >> 16);
    vt[(e0 + 4) * 72 + tok] = (bf16_t)(v.z & 0xffff); vt[(e0 + 5) * 72 + tok] = (bf16_t)(v.z >> 16);
    vt[(e0 + 6) * 72 + tok] = (bf16_t)(v.w & 0xffff); vt[(e0 + 7) * 72 + tok] = (bf16_t)(v.w >> 16);
  }
}

DI void gla_stageA(const Params& p, int item, char* lds) {
  const bf16_t* H0 = (const bf16_t*)(p.ws + OFF_H0);
  float* ckv = (float*)((char*)p.out + OUT_CKV); float* decay = (float*)(p.ws + OFF_DECAY);
  const int b = item >> 9, h = (item >> 7) & 3, n = item & 127;
  const int tok0 = b * SEQ + n * 64;
  const int tid = threadIdx.x, lane = tid & 63, w = tid >> 6, c = lane & 31, hh = lane >> 5;
  gla_cum(p, H0, tok0, h, lds);
  const float* cum = (const float*)(lds + GL_CUM);
  gla_load_vt(H0, tok0, h, lds);
  {
    bf16_t* ke = (bf16_t*)(lds + GL_A);
    for (int i = tid; i < 64 * 64; i += 512) {
      const int tok = i >> 6, d = i & 63;
      const float kv = bf2f(H0[(size_t)(tok0 + tok) * LD_H0 + 256 + h * 64 + d]);
      ke[d * 72 + tok] = f2bf(kv * expf(cum[63 * 65 + d] - cum[tok * 65 + d]));
    }
    if (tid < 64) decay[(size_t)item * 64 + tid] = expf(cum[63 * 65 + tid]);
    {
      float* cg = (float*)(p.ws + OFF_BIG + 128 * MiB) + (size_t)item * 4096;
      for (int i = tid; i < 4096; i += 512) cg[i] = cum[(i >> 6) * 65 + (i & 63)];
    }
  }
  __syncthreads();
  {
    const int db = w & 1, eb = w >> 1;
    f32x16 acc;
#pragma unroll
    for (int i = 0; i < 16; ++i) acc[i] = 0.f;
#pragma unroll
    for (int s = 0; s < 4; ++s) {
      bf16x8 a = *(const bf16x8*)(lds + GL_A + (db * 32 + c) * 144 + s * 32 + hh * 16);
      bf16x8 bb = *(const bf16x8*)(lds + GL_VT + (eb * 32 + c) * 144 + s * 32 + hh * 16);
      acc = MFMA32(a, bb, acc);
    }
#pragma unroll
    for (int i = 0; i < 16; ++i) ckv[(size_t)item * 8192 + (db * 32 + crow(i, hh)) * 128 + eb * 32 + c] = acc[i];
  }
  __syncthreads();
}

DI void gla_scan(const Params& p) {
  float* ckv = (float*)((char*)p.out + OUT_CKV); const float* decay = (const float*)(p.ws + OFF_DECAY);
  for (int e = blockIdx.x * 512 + threadIdx.x; e < 16 * 8192; e += gridDim.x * 512) {
    const int bh = e >> 13, de = e & 8191, d = de >> 7;
    float st = 0.f;
    const float* base = ckv + (size_t)bh * 128 * 8192 + de;
    bf16_t* sbase = (bf16_t*)(p.ws + OFF_BIG + 160 * MiB) + (size_t)bh * 128 * 8192 + de;
    const float* dbase = decay + (size_t)bh * 128 * 64 + d;
    for (int n0 = 0; n0 < 128; n0 += 8) {
      float kv[8], dc[8];
#pragma unroll
      for (int j = 0; j < 8; ++j) { kv[j] = base[(size_t)(n0 + j) * 8192]; dc[j] = dbase[(n0 + j) * 64]; }
#pragma unroll
      for (int j = 0; j < 8; ++j) { sbase[(size_t)(n0 + j) * 8192] = f2bf(st); st = dc[j] * st + kv[j]; }
    }
  }
}

DI void gla_stageC(const Params& p, int item, char* lds) {
  const bf16_t* H0 = (const bf16_t*)(p.ws + OFF_H0);
  const float* sprev = (const float*)((const char*)p.out + OUT_CKV);
  bf16_t* Omix = (bf16_t*)((char*)p.out + OUT_OMIX0);
  const int b = item >> 9, h = (item >> 7) & 3, n = item & 127;
  const int tok0 = b * SEQ + n * 64;
  const int tid = threadIdx.x, lane = tid & 63, w = tid >> 6, c = lane & 31, hh = lane >> 5;
  {
    const float* cg = (const float*)(p.ws + OFF_BIG + 128 * MiB) + (size_t)item * 4096;
    float* cw = (float*)(lds + GL_CUM);
    for (int i = tid; i < 4096; i += 512) cw[(i >> 6) * 65 + (i & 63)] = cg[i];
  }
  __syncthreads();
  const float* cum = (const float*)(lds + GL_CUM);
  gla_load_vt(H0, tok0, h, lds);
  {
    bf16_t* qd = (bf16_t*)(lds + GL_A); bf16_t* ki = (bf16_t*)(lds + GL_B);
    for (int i = tid; i < 64 * 64; i += 512) {
      const int tok = i >> 6, d = i & 63;
      const float cv = cum[tok * 65 + d];
      const float qv = bf2f(H0[(size_t)(tok0 + tok) * LD_H0 + h * 64 + d]);
      const float kv = bf2f(H0[(size_t)(tok0 + tok) * LD_H0 + 256 + h * 64 + d]);
      qd[tok * 72 + d] = f2bf(qv * 0.125f * expf(cv));
      ki[tok * 72 + d] = f2bf(kv * expf(-cv));
    }
    bf16_t* sp = (bf16_t*)(lds + GL_SP);
    const bf16_t* spb = (const bf16_t*)(p.ws + OFF_BIG + 160 * MiB) + (size_t)item * 8192;
    for (int i = tid; i < 1024; i += 512) {
      const int d = i >> 4, e0 = (i & 15) * 8;
      const uint4 v = *(const uint4*)(spb + i * 8);
      sp[(e0 + 0) * 72 + d] = (bf16_t)(v.x & 0xffff); sp[(e0 + 1) * 72 + d] = (bf16_t)(v.x >> 16);
      sp[(e0 + 2) * 72 + d] = (bf16_t)(v.y & 0xffff); sp[(e0 + 3) * 72 + d] = (bf16_t)(v.y >> 16);
      sp[(e0 + 4) * 72 + d] = (bf16_t)(v.z & 0xffff); sp[(e0 + 5) * 72 + d] = (bf16_t)(v.z >> 16);
      sp[(e0 + 6) * 72 + d] = (bf16_t)(v.w & 0xffff); sp[(e0 + 7) * 72 + d] = (bf16_t)(v.w >> 16);
    }
  }
  __syncthreads();
  const int ib = w & 1, eh = w >> 1;
  f32x16 o;
#pragma unroll
  for (int i = 0; i < 16; ++i) o[i] = 0.f;
  {
    f32x16 at[2];
#pragma unroll
    for (int rb = 0; rb < 2; ++rb) {
#pragma unroll
      for (int i = 0; i < 16; ++i) at[rb][i] = 0.f;
#pragma unroll
      for (int s = 0; s < 4; ++s) {
        bf16x8 a = *(const bf16x8*)(lds + GL_B + (rb * 32 + c) * 144 + s * 32 + hh * 16);
        bf16x8 bq = *(const bf16x8*)(lds + GL_A + (ib * 32 + c) * 144 + s * 32 + hh * 16);
        at[rb] = MFMA32(a, bq, at[rb]);
      }
#pragma unroll
      for (int i = 0; i < 16; ++i) if (rb * 32 + crow(i, hh) > ib * 32 + c) at[rb][i] = 0.f;
    }
#pragma unroll
    for (int kb = 0; kb < 2; ++kb)
#pragma unroll
      for (int s = 0; s < 2; ++s) {
        unsigned u0 = pack2(at[kb][8 * s + 0], at[kb][8 * s + 1]), u1 = pack2(at[kb][8 * s + 2], at[kb][8 * s + 3]);
        unsigned u2 = pack2(at[kb][8 * s + 4], at[kb][8 * s + 5]), u3 = pack2(at[kb][8 * s + 6], at[kb][8 * s + 7]);
        uint4 uu = {u0, u1, u2, u3};
        const char* vp = lds + GL_VT + (eh * 32 + c) * 144 + (kb * 32 + s * 16 + hh * 4) * 2;
        uint2 a0 = *(const uint2*)vp, a1 = *(const uint2*)(vp + 16);
        uint4 aa = {a0.x, a0.y, a1.x, a1.y};
        o = MFMA32(__builtin_bit_cast(bf16x8, aa), __builtin_bit_cast(bf16x8, uu), o);
      }
#pragma unroll
    for (int s = 0; s < 4; ++s) {
      bf16x8 a = *(const bf16x8*)(lds + GL_SP + (eh * 32 + c) * 144 + s * 32 + hh * 16);
      bf16x8 bq = *(const bf16x8*)(lds + GL_A + (ib * 32 + c) * 144 + s * 32 + hh * 16);
      o = MFMA32(a, bq, o);
    }
  }
  float ss = 0.f;
#pragma unroll
  for (int i = 0; i < 16; ++i) ss += o[i] * o[i];
  ss += __shfl_xor(ss, 32);
  float* ssq = (float*)(lds + GL_SSQ);
  if (hh == 0) ssq[(ib * 4 + eh) * 32 + c] = ss;
  __syncthreads();
  const float tot = ssq[(ib * 4 + 0) * 32 + c] + ssq[(ib * 4 + 1) * 32 + c] + ssq[(ib * 4 + 2) * 32 + c] + ssq[(ib * 4 + 3) * 32 + c];
  const float rn = rsqrtf(tot * (1.f / 128.f) + LN_EPS);
  const size_t tok = (size_t)tok0 + ib * 32 + c;
#pragma unroll
  for (int g4 = 0; g4 < 4; ++g4) {
    const int e = eh * 32 + 8 * g4 + 4 * hh;
    const uint2 rr = *(const uint2*)(H0 + tok * LD_H0 + 1040 + h * 128 + e);
    const f32x4 gn = *(const f32x4*)(p.in[5] + h * 128 + e);
    float r0 = lo_bf(rr.x), r1 = hi_bf(rr.x), r2 = lo_bf(rr.y), r3 = hi_bf(rr.y);
    f32x4 v;
    v[0] = o[4 * g4 + 0] * rn * gn[0] * (r0 / (1.f + __expf(-r0)));
    v[1] = o[4 * g4 + 1] * rn * gn[1] * (r1 / (1.f + __expf(-r1)));
    v[2] = o[4 * g4 + 2] * rn * gn[2] * (r2 / (1.f + __expf(-r2)));
    v[3] = o[4 * g4 + 3] * rn * gn[3] * (r3 / (1.f + __expf(-r3)));
    *(uint2*)(Omix + tok * 1024 + h * 128 + e) = pack4(v);
  }
  __syncthreads();
}

DI unsigned okey(float s) { s += 0.f; unsigned u = __float_as_uint(s); return (u & 0x80000000u) ? ~u : (u | 0x80000000u); }

template <int NI>
DI void idx_count(const unsigned (&k0)[NI], const unsigned (&k1)[NI], unsigned ca, unsigned cb, int mode, unsigned pa, unsigned pb, int w, int c,
                  int hh, unsigned* part, unsigned (&tot)[4]) {
  unsigned na = 0, nb = 0;
  const int da = w * 32 + c - (int)pa, db = w * 32 + c - (int)pb;
  if (mode == 0) {
#pragma unroll
    for (int i = 0; i < NI; ++i) { na += (k0[i] >= ca) ? 1u : 0u; nb += (k1[i] >= cb) ? 1u : 0u; }
  } else {
#pragma unroll
    for (int i = 0; i < NI; ++i) {
      na += (k0[i] == ca && da < -256 * i) ? 1u : 0u; nb += (k1[i] == cb && db < -256 * i) ? 1u : 0u;
    }
  }
#pragma unroll
  for (int o = 16; o >= 1; o >>= 1) { na += __shfl_xor(na, o); nb += __shfl_xor(nb, o); }
  if (c == 0) { part[w * 4 + 2 * hh] = na; part[w * 4 + 2 * hh + 1] = nb; }
  __syncthreads();
#pragma unroll
  for (int q = 0; q < 4; ++q) tot[q] = 0;
#pragma unroll
  for (int ww = 0; ww < 8; ++ww) {
    const uint4 v = *(const uint4*)(part + ww * 4);
    tot[0] += v.x; tot[1] += v.y; tot[2] += v.z; tot[3] += v.w;
  }
}

template <int NI>
DI void idx_item_t(const Params& p, int b, int t0, char* lds) {
  const bf16_t* H1 = (const bf16_t*)(p.ws + OFF_H1);
  const float* WI = (const float*)(p.ws + OFF_WI);
  unsigned* mask = (unsigned*)(p.ws + OFF_MASK);
  const size_t tb = (size_t)b * SEQ;
  int tid = threadIdx.x;
  asm volatile("" : "+v"(tid));
  const int lane = tid & 63, w = __builtin_amdgcn_readfirstlane(tid >> 6), c = lane & 31, hh = lane >> 5;
  bf16x8 af[4];
  {
    const int m = c, r = (m & 3) + 4 * (m >> 3), ql = 2 * ((m >> 2) & 1) + (r >> 3), head = r & 7;
    const bf16_t* qp = H1 + (tb + t0 + ql) * LD_H1 + 1536 + head * 64 + hh * 32;
#pragma unroll
    for (int j = 0; j < 4; ++j) af[j] = *(const bf16x8*)(qp + j * 8);
  }
  float wq0[8], wq1[8];
  {
    const f32x4 a0 = *(const f32x4*)(WI + (tb + t0 + 2 * hh) * 8), a1 = *(const f32x4*)(WI + (tb + t0 + 2 * hh) * 8 + 4);
    const f32x4 b0 = *(const f32x4*)(WI + (tb + t0 + 2 * hh + 1) * 8), b1 = *(const f32x4*)(WI + (tb + t0 + 2 * hh + 1) * 8 + 4);
#pragma unroll
    for (int j = 0; j < 4; ++j) { wq0[j] = a0[j] * 0.125f; wq0[4 + j] = a1[j] * 0.125f; wq1[j] = b0[j] * 0.125f; wq1[4 + j] = b1[j] * 0.125f; }
  }
  const int tq0 = t0 + 2 * hh, tq1 = tq0 + 1;
  unsigned k0[NI], k1[NI];
  {
    const bf16_t* kp = H1 + (tb + w * 32 + (lane >> 3)) * LD_H1 + 2048 + (lane & 7) * 8;
    char* tbuf = lds + 65536 + w * 4608;
    const int wofs = (lane >> 3) * 144 + (lane & 7) * 16, rofs = c * 144 + hh * 64;
    const int dq0 = w * 32 + c - tq0;
    bf16x8 ring[4][4], fr[2][4];
#pragma unroll
    for (int i = 0; i < 3; ++i) {
#pragma unroll
      for (int j = 0; j < 4; ++j) ring[i][j] = *(const bf16x8*)(kp + (size_t)j * 8 * LD_H1);
      kp += (size_t)256 * LD_H1;
    }
#pragma unroll
    for (int j = 0; j < 4; ++j) *(bf16x8*)(tbuf + wofs + j * 8 * 144) = ring[0][j];
#pragma unroll
    for (int j = 0; j < 4; ++j) fr[0][j] = *(const bf16x8*)(tbuf + rofs + j * 16);
    __builtin_amdgcn_sched_barrier(0);
#pragma unroll
    for (int i = 0; i < NI; ++i) {
      if (i + 3 < NI) {
#pragma unroll
        for (int j = 0; j < 4; ++j) ring[(i + 3) % 4][j] = *(const bf16x8*)(kp + (size_t)j * 8 * LD_H1);
        kp += (size_t)256 * LD_H1;
      }
      if (i + 1 < NI) {
#pragma unroll
        for (int j = 0; j < 4; ++j) *(bf16x8*)(tbuf + wofs + j * 8 * 144) = ring[(i + 1) % 4][j];
#pragma unroll
        for (int j = 0; j < 4; ++j) fr[(i + 1) & 1][j] = *(const bf16x8*)(tbuf + rofs + j * 16);
      }
      __builtin_amdgcn_sched_barrier(0);
      f32x16 acc;
#pragma unroll
      for (int r = 0; r < 16; ++r) acc[r] = 0.f;
#pragma unroll
      for (int j = 0; j < 4; ++j) acc = MFMA32(af[j], fr[i & 1][j], acc);
      float s0 = 0.f, s1 = 0.f;
#pragma unroll
      for (int r = 0; r < 8; ++r) { s0 += wq0[r] * fmaxf(acc[r], 0.f); s1 += wq1[r] * fmaxf(acc[8 + r], 0.f); }
      k0[i] = (dq0 <= -256 * i) ? okey(s0) : 0u;
      k1[i] = (dq0 <= 1 - 256 * i) ? okey(s1) : 0u;
      asm volatile("" : "+v"(k0[i]), "+v"(k1[i]));
      __builtin_amdgcn_sched_barrier(0);
    }
  }
  constexpr int CAP = 1024;
  unsigned* part = (unsigned*)lds;
  unsigned* ctl = (unsigned*)(lds + 256);
  unsigned* samp = (unsigned*)(lds + 512);
  unsigned* ckey = (unsigned*)(lds + 512 + 16384);
  unsigned* cpos = (unsigned*)(lds + 512 + 32768);
  unsigned* img = (unsigned*)(lds + 512 + 49152);
  unsigned Tm[4], Pc[4]; bool done[4];
#pragma unroll
  for (int q = 0; q < 4; ++q) { Pc[q] = 0; done[q] = (t0 + q + 1 <= 256); Tm[q] = 0; }
  const bool use_sample = (NI >= 8) && (t0 + 4 > 1024);
  if (tid < 4) ctl[tid] = 0;
  img[tid] = 0u; img[tid + 512] = 0u;
  if (use_sample) {
#pragma unroll
    for (int j = 0; j < NI / 8; ++j) {
      samp[(2 * hh) * 1024 + (j * 8 + w) * 32 + c] = k0[8 * j];
      samp[(2 * hh + 1) * 1024 + (j * 8 + w) * 32 + c] = k1[8 * j];
    }
  }
  __syncthreads();
  if (use_sample) {
    if (w < 4) {
      constexpr int SR = (NI / 8) * 4 > 0 ? (NI / 8) * 4 : 1;
      unsigned sk[SR];
#pragma unroll
      for (int r = 0; r < SR; ++r) sk[r] = samp[w * 1024 + r * 64 + lane];
      unsigned nvs = 0;
#pragma unroll
      for (int r = 0; r < SR; ++r) nvs += (unsigned)__popcll(__ballot(sk[r] >= 1u));
      const float f = (float)nvs / (float)(t0 + w + 1);
      const unsigned R = (unsigned)(256.f * f + 4.f * sqrtf(256.f * f * (1.f - f))) + 2u;
      unsigned T = 0;
      if (R < nvs) {
        for (int bit = 31; bit >= 0; --bit) {
          const unsigned cand = T | (1u << bit);
          unsigned n = 0;
#pragma unroll
          for (int r = 0; r < SR; ++r) n += (unsigned)__popcll(__ballot(sk[r] >= cand));
          if (n >= R) T = cand;
          if (n == R) break;
        }
      }
      if (lane == 0) ctl[4 + w] = T < 1u ? 1u : T;
    }
    __syncthreads();
  }
  {
    const unsigned loa = use_sample ? ctl[4 + 2 * hh] : 1u, lob = use_sample ? ctl[4 + 2 * hh + 1] : 1u;
    const int pbase = w * 32 + c;
    unsigned na = 0, nb = 0;
#pragma unroll
    for (int i = 0; i < NI; ++i) { na += (k0[i] >= loa) ? 1u : 0u; nb += (k1[i] >= lob) ? 1u : 0u; }
    unsigned ia = na, ib = nb;
#pragma unroll
    for (int o = 1; o < 32; o <<= 1) {
      const unsigned ta = __shfl_up(ia, o, 32), tb2 = __shfl_up(ib, o, 32);
      if (c >= o) { ia += ta; ib += tb2; }
    }
    unsigned basea = 0, baseb = 0;
    if (c == 31) { basea = atomicAdd(&ctl[2 * hh], ia); baseb = atomicAdd(&ctl[2 * hh + 1], ib); }
    basea = __shfl(basea, 31, 32); baseb = __shfl(baseb, 31, 32);
    unsigned sa = basea + ia - na, sb = baseb + ib - nb;
#pragma unroll
    for (int i = 0; i < NI; ++i) {
      if (k0[i] >= loa) { if (sa < (unsigned)CAP) { ckey[(2 * hh) * CAP + sa] = k0[i]; cpos[(2 * hh) * CAP + sa] = (unsigned)(pbase + 256 * i); } ++sa; }
      if (k1[i] >= lob) { if (sb < (unsigned)CAP) { ckey[(2 * hh + 1) * CAP + sb] = k1[i]; cpos[(2 * hh + 1) * CAP + sb] = (unsigned)(pbase + 256 * i); } ++sb; }
    }
  }
  __syncthreads();
  bool fast_ok = true;
#pragma unroll
  for (int q = 0; q < 4; ++q) { const unsigned n = ctl[q]; if (!done[q] && (n < 256u || n > (unsigned)CAP)) fast_ok = false; }
  if (fast_ok) {
    if (w < 4) {
      const unsigned ncand = ctl[w];
      unsigned ck[CAP / 64], cp[CAP / 64];
#pragma unroll
      for (int r = 0; r < CAP / 64; ++r) { const unsigned idx = r * 64 + lane; const bool v = idx < ncand; ck[r] = v ? ckey[w * CAP + idx] : 0u; cp[r] = v ? cpos[w * CAP + idx] : 0u; }
      unsigned T = 0; bool hit = (t0 + w + 1 <= 256);
      if (!hit) {
        for (int bit = 31; bit >= 0; --bit) {
          const unsigned cand = T | (1u << bit);
          unsigned n = 0;
#pragma unroll
          for (int r = 0; r < CAP / 64; ++r) n += (unsigned)__popcll(__ballot(ck[r] >= cand));
          if (n >= 256u) T = cand;
          if (n == 256u) { hit = true; break; }
        }
      } else T = 1u;
      unsigned tm, pc = 0;
      if (hit) tm = T - 1u;
      else {
        tm = T;
        unsigned ngt = 0;
#pragma unroll
        for (int r = 0; r < CAP / 64; ++r) ngt += (unsigned)__popcll(__ballot(ck[r] > T));
        const unsigned rr = 256u - ngt;
        for (int bit = 13; bit >= 0; --bit) {
          const unsigned pcand = pc | (1u << bit);
          unsigned n = 0;
#pragma unroll
          for (int r = 0; r < CAP / 64; ++r) n += (unsigned)__popcll(__ballot(ck[r] == T && cp[r] < pcand));
          if (n <= rr) pc = pcand;
        }
      }
#pragma unroll
      for (int r = 0; r < CAP / 64; ++r) {
        const bool sel = (ck[r] > tm) || (ck[r] == tm && cp[r] < pc);
        if (sel) atomicOr(&img[w * 256 + (cp[r] >> 5)], 1u << (cp[r] & 31u));
      }
    }
    __syncthreads();
    for (int idx = tid; idx < 4 * NI * 8; idx += 512) {
      const int q = idx / (NI * 8), kt = idx % (NI * 8);
      mask[(tb + t0 + q) * 256 + kt] = img[q * 256 + kt];
    }
    __syncthreads();
    return;
  } else {
    unsigned T[4];
#pragma unroll
    for (int q = 0; q < 4; ++q) T[q] = 0;
  int it = 0;
    for (int bit = 31; bit >= 0; --bit) {
      if (done[0] && done[1] && done[2] && done[3]) break;
      unsigned cand[4];
  #pragma unroll
      for (int q = 0; q < 4; ++q) cand[q] = T[q] | (1u << bit);
      unsigned tot[4];
      idx_count<NI>(k0, k1, hh ? cand[2] : cand[0], hh ? cand[3] : cand[1], 0, 0, 0, w, c, hh, part + (it & 1) * 32, tot);
      ++it;
  #pragma unroll
      for (int q = 0; q < 4; ++q)
        if (!done[q]) {
          if (tot[q] >= 256u) T[q] = cand[q];
          if (tot[q] == 256u) { done[q] = true; Tm[q] = cand[q] - 1u; }
        }
    }
    if (!(done[0] && done[1] && done[2] && done[3])) {
      unsigned tot[4], cand[4], rr[4];
  #pragma unroll
      for (int q = 0; q < 4; ++q) cand[q] = T[q] + 1u;
      idx_count<NI>(k0, k1, hh ? cand[2] : cand[0], hh ? cand[3] : cand[1], 0, 0, 0, w, c, hh, part + (it & 1) * 32, tot);
      ++it;
  #pragma unroll
      for (int q = 0; q < 4; ++q) { rr[q] = 256u - tot[q]; if (!done[q]) Tm[q] = T[q]; }
      unsigned P[4] = {0, 0, 0, 0};
      for (int bit = 13; bit >= 0; --bit) {
        unsigned pc[4];
  #pragma unroll
        for (int q = 0; q < 4; ++q) pc[q] = P[q] | (1u << bit);
        idx_count<NI>(k0, k1, hh ? T[2] : T[0], hh ? T[3] : T[1], 1, hh ? pc[2] : pc[0], hh ? pc[3] : pc[1], w, c, hh, part + (it & 1) * 32, tot);
        ++it;
  #pragma unroll
        for (int q = 0; q < 4; ++q) if (tot[q] <= rr[q]) P[q] = pc[q];
      }
  #pragma unroll
      for (int q = 0; q < 4; ++q) if (!done[q]) Pc[q] = P[q];
    }
}
  const unsigned tma = hh ? Tm[2] : Tm[0], tmb = hh ? Tm[3] : Tm[1], pca = hh ? Pc[2] : Pc[0], pcb = hh ? Pc[3] : Pc[1];
  const int dpa = w * 32 + c - (int)pca, dpb = w * 32 + c - (int)pcb;
#pragma unroll
  for (int i = 0; i < NI; ++i) {
    const int kt = w + 8 * i;
    const bool sa = (k0[i] > tma) || (k0[i] == tma && dpa < -256 * i);
    const bool sb = (k1[i] > tmb) || (k1[i] == tmb && dpb < -256 * i);
    const u64 ba = __ballot(sa), bb = __ballot(sb);
    if (c == 0) {
      mask[(tb + tq0) * 256 + kt] = hh ? (unsigned)(ba >> 32) : (unsigned)ba;
      mask[(tb + tq1) * 256 + kt] = hh ? (unsigned)(bb >> 32) : (unsigned)bb;
    }
  }
  __syncthreads();
}

DI void idx_item(const Params& p, int item, char* lds) {
  const int b = item & 3, t0 = (item >> 2) * 4;
  const int ni = (t0 + 4 + 255) >> 8;
  if (ni <= 4) idx_item_t<4>(p, b, t0, lds);
  else if (ni <= 8) idx_item_t<8>(p, b, t0, lds);
  else if (ni <= 12) idx_item_t<12>(p, b, t0, lds);
  else if (ni <= 16) idx_item_t<16>(p, b, t0, lds);
  else if (ni <= 20) idx_item_t<20>(p, b, t0, lds);
  else if (ni <= 24) idx_item_t<24>(p, b, t0, lds);
  else if (ni <= 28) idx_item_t<28>(p, b, t0, lds);
  else idx_item_t<32>(p, b, t0, lds);
}

DI void s5_scan(const Params& p) {
  const float* apow = (const float*)(p.ws + OFF_APOW); const float* xend = (const float*)(p.ws + OFF_XEND);
  bf16_t* Ug = (bf16_t*)((char*)p.out + OUT_UG);
  for (int gid = blockIdx.x * 512 + threadIdx.x; gid < 4 * 32 * 64 * 16; gid += gridDim.x * 512) {
    const int seg = gid & 15, pp = (gid >> 4) & 63, g = (gid >> 10) & 31, b = gid >> 15;
    const float ar = apow[2 * ((g * 33 + 32) * 64 + pp)], ai = apow[2 * ((g * 33 + 32) * 64 + pp) + 1];
    const size_t row0 = (size_t)(g * 1024 + b * 256 + seg * 16);
    float er[16], ei[16];
#pragma unroll
    for (int j = 0; j < 16; ++j) { const float2 e = *(const float2*)(xend + (row0 + j) * 128 + 2 * pp); er[j] = e.x; ei[j] = e.y; }
    float lr[16], li[16], xr = 0.f, xi = 0.f;
#pragma unroll
    for (int j = 0; j < 16; ++j) { lr[j] = xr; li[j] = xi; const float nr = ar * xr - ai * xi + er[j], ni = ar * xi + ai * xr + ei[j]; xr = nr; xi = ni; }
    float pr = ar, pi = ai;
#pragma unroll
    for (int k = 0; k < 4; ++k) { const float nr = pr * pr - pi * pi, ni = 2.f * pr * pi; pr = nr; pi = ni; }
    float cr = 0.f, ci = 0.f;
#pragma unroll
    for (int sidx = 0; sidx < 15; ++sidx) {
      const float sr = __shfl(xr, sidx, 16), si = __shfl(xi, sidx, 16);
      if (seg > sidx) { const float nr = pr * cr - pi * ci + sr, ni = pr * ci + pi * cr + si; cr = nr; ci = ni; }
    }
#pragma unroll
    for (int j = 0; j < 16; ++j) {
      *(unsigned*)(Ug + (row0 + j) * 640 + 512 + 2 * pp) = pack2(lr[j] + cr, li[j] + ci);
      const float nr = ar * cr - ai * ci, ni = ar * ci + ai * cr; cr = nr; ci = ni;
    }
  }
}

DI void mlp_and_ln(const Params& p, int layer, int ph, char* lds) {
}

template <int ph> DI void run_phase(const Params& p, char* lds) {
  char* ws = p.ws; char* ob = (char*)p.out;
  const int nb = gridDim.x, bid = blockIdx.x;
  switch (ph) {
    case 0: phase_prep(p, lds); break;
    case 1: {
      big_gemm8(lds, (const bf16_t*)(ws + OFF_XB), (const bf16_t*)(ws + OFF_WT_IN0), 2048, 1024, El8Bf16{(bf16_t*)(ws + OFF_H0), LD_H0});
      s5_ktab(p);
    } break;
    case 2: {
      const bf16_t* H0 = (const bf16_t*)(ws + OFF_H0);
      float* rs = (float*)(lds + LDS_AUX);
      for (int t = bid; t < 128 * 14; t += nb) {
        const int mt = t / 14, nt = t % 14, m0 = mt * 256;
        const bool isq = nt < 6;
        const int coff = isq ? 1552 : 1808, kk = isq ? 256 : 128;
        {
          const int row = threadIdx.x >> 1, half = threadIdx.x & 1, cnt = kk / 2;
          const bf16_t* src = H0 + (size_t)(m0 + row) * LD_H0 + coff + half * cnt;
          float s = 0.f;
          for (int i = 0; i < cnt; i += 8) {
            const uint4 v = *(const uint4*)(src + i);
            float a;
            a = lo_bf(v.x); s += a * a; a = hi_bf(v.x); s += a * a; a = lo_bf(v.y); s += a * a; a = hi_bf(v.y); s += a * a;
            a = lo_bf(v.z); s += a * a; a = hi_bf(v.z); s += a * a; a = lo_bf(v.w); s += a * a; a = hi_bf(v.w); s += a * a;
          }
          s += __shfl_xor(s, 1);
          if (half == 0) rs[row] = rsqrtf(s / (float)kk + LN_EPS);
          __syncthreads();
        }
        if (isq) {
          EpiUQ epi{(bf16_t*)(ws + OFF_Q0), (const int*)p.in[1], rs, m0};
          gemm_tile(H0 + 1552, LD_H0, (const bf16_t*)(ws + OFF_WT_UQ), 256, 256, m0, nt * 128, lds, epi);
        } else {
          EpiUKV epi{(bf16_t*)(ws + OFF_K0), (bf16_t*)(ws + OFF_VT0), rs, m0};
          gemm_tile(H0 + 1808, LD_H0, (const bf16_t*)(ws + OFF_WT_UKV), 128, 128, m0, (nt - 6) * 128, lds, epi);
        }
        __syncthreads();
      }
      {
        bf16_t* Kb = (bf16_t*)(ws + OFF_K0); const int* pos = (const int*)p.in[1];
        for (int i = bid * 512 + threadIdx.x; i < NTOK * 16; i += nb * 512) {
          const int row = i >> 4, fi = i & 15;
          const float t1 = bf2f(H0[(size_t)row * LD_H0 + 1936 + fi]), t2 = bf2f(H0[(size_t)row * LD_H0 + 1952 + fi]);
          float cs, sn; rope_cs(pos[row], fi, cs, sn);
          const bf16_t o1 = f2bf(t1 * cs - t2 * sn), o2 = f2bf(t2 * cs + t1 * sn);
#pragma unroll
          for (int h = 0; h < 8; ++h) { Kb[(size_t)row * 768 + h * 96 + 64 + fi] = o1; Kb[(size_t)row * 768 + h * 96 + 80 + fi] = o2; }
        }
      }
      for (int it = bid; it < 2048; it += nb) gla_stageA(p, it, lds);
    } break;
    case 3: gla_scan(p); break;
    case 4: {
      const float sl2 = 0.10206207261596577f * 1.4426950408889634f;
      for (int u = bid; u < 1024; u += nb) {
        const int j = u & 255, rd = u >> 8, bh = j >> 3, sub = j & 7;
        const int qb = (rd == 0) ? sub : (rd == 1) ? 15 - sub : (rd == 2) ? 16 + sub : 31 - sub;
        attn_item<96, false>((const bf16_t*)(ws + OFF_Q0), 768, (const bf16_t*)(ws + OFF_K0), 768, (const bf16_t*)(ws + OFF_VT0),
                             (bf16_t*)(ob + OUT_OMIX0), 512, nullptr, bh >> 3, bh & 7, qb, sl2, lds);
      }
      for (int it = bid; it < 2048; it += nb) gla_stageC(p, it, lds);
    } break;
    case 5: case 15: {
      const bool l1 = ph == 15;
      const bf16_t* A = (const bf16_t*)(ob + (l1 ? OUT_OMIX1 : OUT_OMIX0));
      const bf16_t* Bt = (const bf16_t*)(ws + (l1 ? OFF_WT_OUT1 : OFF_WT_OUT0));
      if (l1) big_gemm8(lds, A, Bt, 1024, 1024, El8ResidB{(const bf16_t*)(ws + OFF_XB), (float*)(ws + OFF_XF)});
      else big_gemm8(lds, A, Bt, 1024, 1024, El8ResidF{p.in[0], (float*)(ws + OFF_XF)});
    } break;
    case 6: phase_ln((const float*)(ws + OFF_XF), nullptr, (bf16_t*)(ws + OFF_XB), p.in[11], p.in[12]); break;
    case 16: phase_ln((const float*)(ws + OFF_XF), nullptr, (bf16_t*)(ws + OFF_XB), p.in[29], p.in[30]); break;
    case 7: case 17: {
      const bf16_t* Bt = (const bf16_t*)(ws + (ph == 17 ? OFF_WT_11 : OFF_WT_10));
      big_gemm8(lds, (const bf16_t*)(ws + OFF_XB), Bt, 4096, 1024, El8Relu2{(bf16_t*)(ws + OFF_HMID), 4096});
    } break;
    case 8: case 18: {
      const bf16_t* Bt = (const bf16_t*)(ws + (ph == 18 ? OFF_WT_21 : OFF_WT_20));
      big_gemm8(lds, (const bf16_t*)(ws + OFF_HMID), Bt, 1024, 4096, El8ResidB{(const bf16_t*)(ws + OFF_XB), (float*)(ws + OFF_XF)});
    } break;
    case 9: phase_ln((const float*)(ws + OFF_XF), nullptr, (bf16_t*)(ws + OFF_XB), p.in[15], p.in[16]); break;
    case 19: phase_ln((const float*)(ws + OFF_XF), p.out, nullptr, p.in[33], p.in[34]); break;
    case 10: {
      ElH1 el{(bf16_t*)(ws + OFF_H1), (bf16_t*)(ws + OFF_VT1), (float*)(ws + OFF_WI), (bf16_t*)(ob + OUT_UG)};
      {
        pg8::Gemm g{(const bf16_t*)(ws + OFF_XB), (const bf16_t*)(ws + OFF_WT_IN1), NTOK, 2048, 1024}; pg8::StaticOrder S; S.init(NTOK, 2048, (int)gridDim.x, (int)blockIdx.x);
        P8H1 E{(bf16_t*)(ws + OFF_H1), (bf16_t*)(ws + OFF_VT1)};
        pg8::gemm_phase<P8H1, pg8::StaticOrder, true, true>((PG8_LAS unsigned char*)lds, g, S, E);
        __syncthreads();
      }
      EpiEl<ElH1> epi{el};
      for (int t = bid; t < 128 * 5; t += nb) gemm_tile((const bf16_t*)(ws + OFF_XB), 1024, (const bf16_t*)(ws + OFF_WT_IN1), 1024, 1024, (t / 5) * 256, 2048 + (t % 5) * 128, lds, epi);
      s5_expand(p);
    } break;
    case 11: {
      for (int t = bid; t < 32 * 4; t += nb) {
        const int g = t >> 2, mt = t & 3;
        EpiF32 epi{(float*)(ws + OFF_XEND) + (size_t)g * 1024 * 128, 128};
        gemm_tile((const bf16_t*)(ob + OUT_UG) + (size_t)g * 1024 * 640, 640, (const bf16_t*)(ob + OUT_E) + (size_t)g * 128 * 512, 512, 512, mt * 256, 0, lds, epi);
      }
      for (int it = bid; it < 8192; it += nb) idx_item(p, it, lds);
    } break;
    case 12: {
      s5_scan(p);
      const float sl2 = 0.125f * 1.4426950408889634f;
      for (int u = bid; u < 1024; u += nb) {
        const int j = u & 255, rd = u >> 8, bh = j >> 3, sub = j & 7;
        const int qb = (rd == 0) ? sub : (rd == 1) ? 15 - sub : (rd == 2) ? 16 + sub : 31 - sub;
        attn_item<64, true>((const bf16_t*)(ws + OFF_H1), LD_H1, (const bf16_t*)(ws + OFF_H1) + 512, LD_H1, (const bf16_t*)(ws + OFF_VT1),
                            (bf16_t*)(ob + OUT_OMIX1), 0, (const unsigned*)(ws + OFF_MASK), bh >> 3, bh & 7, qb, sl2, lds);
      }
    } break;
    case 13: {
      for (int t = bid; t < 32 * 16; t += nb) {
        const int g = t >> 4, mt = (t >> 2) & 3, nt = t & 3;
        EpiS5Y epi{(const bf16_t*)(ob + OUT_UG), p.in[24], (bf16_t*)(ws + OFF_YACT), g};
        gemm_tile((const bf16_t*)(ob + OUT_UG) + (size_t)g * 1024 * 640, 640, (const bf16_t*)(ob + OUT_TF) + (size_t)g * 512 * 640, 640, 640, mt * 256, nt * 128, lds, epi);
      }
    } break;
    case 14: {
      EpiGLU epi{(const bf16_t*)(ws + OFF_YACT), p.in[27], (bf16_t*)(ob + OUT_OMIX1)};
      for (int t = bid; t < 128 * 4; t += nb) gemm_tile((const bf16_t*)(ws + OFF_YACT), 512, (const bf16_t*)(ws + OFF_WT_GLU), 512, 512, (t >> 2) * 256, (t & 3) * 128, lds, epi);
    } break;
    default: break;
  }
}


#define LAS __attribute__((address_space(3)))
#define XB_TMO      128
#define XB_XCNT(j)  (256  + 64 * (j))
#define XB_XSUB(j)  (1280 + 64 * (j))
#define XB_XGEN(j)  (2304 + 64 * (j))
#define XB_TOP      3328
#define XB_TOPGEN   3392
#define XCD_BAR_WORDS 3456
#define XB_SPIN_CAP (1u << 18)

__device__ __forceinline__ unsigned xb_ld(unsigned* p)              { return __hip_atomic_load(p, __ATOMIC_RELAXED, __HIP_MEMORY_SCOPE_AGENT); }
__device__ __forceinline__ unsigned xb_add(unsigned* p, unsigned v) { return __hip_atomic_fetch_add(p, v, __ATOMIC_RELAXED, __HIP_MEMORY_SCOPE_AGENT); }
__device__ __forceinline__ unsigned xb_xcc_id() { return (unsigned)__builtin_amdgcn_s_getreg((3 << 11) | 20) & 0xFu; }
#define XB_SPIN(cond, bar) do { unsigned _sp = 0; while (cond) { __builtin_amdgcn_s_sleep(1); \
    if ((++_sp & 255u) == 0u) { if (xb_ld(&(bar)[XB_TMO])) break; if (_sp > XB_SPIN_CAP) { atomicAdd(&(bar)[XB_TMO], 1u); break; } } } } while (0)

struct XcdBarrier {
    unsigned* bar; unsigned x;
    volatile LAS unsigned* st;
};

__device__ __forceinline__ XcdBarrier xcd_barrier_post(unsigned* bar, volatile LAS unsigned* st) {
    XcdBarrier b; b.bar = bar; b.x = xb_xcc_id(); b.st = st;
    if (threadIdx.x == 0) (void)xb_add(&bar[XB_XCNT(b.x)], 1u);
    return b;
}
__device__ __forceinline__ void xcd_barrier_complete(unsigned* bar, unsigned x, unsigned& nloc, unsigned& nx) {
    const unsigned G = gridDim.x * gridDim.y * gridDim.z;
    unsigned sum, cnt, mine, sp = 0u;
    for (;;) {
        sum = 0u; cnt = 0u; mine = 0u;
#pragma unroll
        for (unsigned j = 0; j < 16; ++j) { const unsigned c = xb_ld(&bar[XB_XCNT(j)]); sum += c; cnt += (c > 0u) ? 1u : 0u; mine = (j == x) ? c : mine; }
        if (sum == G) break;
        __builtin_amdgcn_s_sleep(1);
        if ((++sp & 255u) == 0u) { if (xb_ld(&bar[XB_TMO])) break; if (sp > XB_SPIN_CAP) { atomicAdd(&bar[XB_TMO], 1u); break; } }
    }
    nloc = mine > 0u ? mine : 1u; nx = cnt > 0u ? cnt : 1u;
}

__device__ __forceinline__ void xcd_barrier(const XcdBarrier& b) {
    asm volatile("s_waitcnt vmcnt(0)" ::: "memory");
    __syncthreads();
    if (threadIdx.x == 0) {
        unsigned* bar = b.bar;
        __builtin_amdgcn_s_waitcnt(0);
        unsigned nloc = b.st[0], nx = b.st[1];
        if (nloc == 0u) { xcd_barrier_complete(bar, b.x, nloc, nx); b.st[0] = nloc; b.st[1] = nx; }
        const unsigned old = xb_add(&bar[XB_XSUB(b.x)], 1u);
        const unsigned gen = old / nloc;
        if (old + 1u == (gen + 1u) * nloc) {
            __builtin_amdgcn_fence(__ATOMIC_RELEASE, "agent");
            asm volatile("s_waitcnt vmcnt(0)" ::: "memory");
            const unsigned og = xb_add(&bar[XB_TOP], 1u);
            const unsigned tg = og / nx;
            if (og + 1u == (tg + 1u) * nx) xb_add(&bar[XB_TOPGEN], 1u);
            else XB_SPIN(xb_ld(&bar[XB_TOPGEN]) == tg, bar);
            __builtin_amdgcn_fence(__ATOMIC_ACQUIRE, "agent");
            xb_add(&bar[XB_XGEN(b.x)], 1u);
            asm volatile("s_waitcnt vmcnt(0)" ::: "memory");
        } else {
            XB_SPIN(xb_ld(&bar[XB_XGEN(b.x)]) == gen, bar);
            __builtin_amdgcn_fence(__ATOMIC_ACQUIRE, "agent");
            asm volatile("s_waitcnt vmcnt(0)" ::: "memory");
        }
    }
    __syncthreads();
}

__global__ void __launch_bounds__(512) mega(Params p) {
  extern __shared__ __attribute__((aligned(16))) char smem[];
  cg::grid_group grid = cg::this_grid();
  volatile LAS unsigned* bst = (volatile LAS unsigned*)(LAS char*)(smem + LDS_TOTAL - 16);
  if (threadIdx.x == 0) { bst[0] = 0u; bst[1] = 0u; }
  __syncthreads();
  const XcdBarrier xbar = xcd_barrier_post((unsigned*)(p.ws + OFF_MISC + 7 * MiB), bst);
  if (p.ph_lo > 1000) grid.sync();
#define GBAR() xcd_barrier(xbar)
#define STEP(PH) if (PH >= p.ph_lo && PH <= p.ph_hi) { run_phase<PH>(p, smem); if ((p.dup >> PH) & 1u) { GBAR(); run_phase<PH>(p, smem); } if (PH < p.ph_hi) GBAR(); }
  STEP(0) STEP(1) STEP(2) STEP(3) STEP(4) STEP(5) STEP(6) STEP(7) STEP(8) STEP(9)
  STEP(10) STEP(11) STEP(12) STEP(13) STEP(14) STEP(15) STEP(16) STEP(17) STEP(18) STEP(19)
}

#ifndef DUP_MASK
#define DUP_MASK 0u
#endif
#ifndef MULTI_LAUNCH
#define MULTI_LAUNCH 0
#endif

extern "C" void kernel_launch(void* const* d_in, const int* in_sizes, int n_in, void* d_out, int out_size,
                              void* d_ws, size_t ws_size, hipStream_t stream) {
  constexpr size_t kDynLds = LDS_TOTAL;
  static int grid_blocks = 0;
  if (!grid_blocks) {
    (void)hipFuncSetAttribute((const void*)mega, hipFuncAttributeMaxDynamicSharedMemorySize, (int)kDynLds);
    int dev = 0, cus = 0, per_cu = 0;
    (void)hipGetDevice(&dev);
    (void)hipDeviceGetAttribute(&cus, hipDeviceAttributeMultiprocessorCount, dev);
    (void)hipOccupancyMaxActiveBlocksPerMultiprocessor(&per_cu, mega, 512, kDynLds);
    if (per_cu < 1) per_cu = 1;
    if (per_cu > 1) per_cu = 1;
    grid_blocks = cus * per_cu;
  }
  Params p{};
  for (int i = 0; i < 35; ++i) p.in[i] = (const float*)d_in[i];
  p.out = (float*)d_out; p.ws = (char*)d_ws; p.dup = DUP_MASK;
#if MULTI_LAUNCH
  for (int ph = 0; ph < 20; ++ph) {
    p.ph_lo = ph; p.ph_hi = ph;
    hipLaunchKernelGGL(mega, dim3(grid_blocks), dim3(512), kDynLds, stream, p);
  }
#else
  p.ph_lo = 0; p.ph_hi = 19;
  (void)hipMemsetAsync((char*)d_ws + OFF_MISC + 7 * MiB, 0, 16384, stream);
  void* args[] = {&p};
  hipError_t e = hipLaunchCooperativeKernel((void*)mega, dim3(grid_blocks), dim3(512), args, kDynLds, stream);
  if (e != hipSuccess) fprintf(stderr, "cooperative launch failed: %s (grid %d)\n", hipGetErrorString(e), grid_blocks);
#endif
}
#ifdef PHASE_TEST
template <int PH> __global__ void __launch_bounds__(512) tk(Params p) { extern __shared__ __attribute__((aligned(16))) char smem2[]; run_phase<PH>(p, smem2); }
template __global__ void tk<0>(Params); template __global__ void tk<1>(Params); template __global__ void tk<2>(Params); template __global__ void tk<3>(Params);
template __global__ void tk<4>(Params); template __global__ void tk<5>(Params); template __global__ void tk<6>(Params); template __global__ void tk<7>(Params);
template __global__ void tk<8>(Params); template __global__ void tk<10>(Params); template __global__ void tk<11>(Params); template __global__ void tk<12>(Params);
template __global__ void tk<13>(Params); template __global__ void tk<14>(Params); template __global__ void tk<19>(Params);
#endif
```
